# Optimizing an MI355X kernel written in HIP

```python
import jax
import jax.numpy as jnp
from jax import lax
import numpy as np

D_MODEL = 2048
BATCH = 32
SEQ = 256
DEPTH = 2
DEC_BATCH = 4
DEC_SEQ = 1024
PAST_LEN = 256

GRID_W = 64
CHUNK = 128
A_HEADS = 4
A_WIDTH = D_MODEL // 4
B_GROUPS = 4
B_WIDTH = D_MODEL // 4
B_GROUP_DIM = B_WIDTH // B_GROUPS
C_WIDTH = D_MODEL // 2
C_HEAD_DIM = 64
C_HEADS = C_WIDTH // C_HEAD_DIM
N_DIR = 2
DECAY_RANK = 64
ICLR_RANK = 64
GATE_RANK = 160
C_IN = 3 * C_WIDTH + N_DIR * DECAY_RANK + N_DIR * ICLR_RANK + GATE_RANK
IN_COLS = 2 * A_WIDTH + B_WIDTH + C_IN
MIX_WIDTH = A_WIDTH + B_WIDTH + C_WIDTH
D_FF = 5632
N_MOD = 9
RMS_EPS = 1e-6
LN_EPS = 1e-5
LNX_EPS = 64e-5

kernel_name = "hybrid_gmlp_fnet_rwkv7_diffusion_step"


def _rmsnorm(x, g):
    xf = x.astype(jnp.float32)
    y = xf * lax.rsqrt(jnp.mean(xf * xf, axis=-1, keepdims=True) + RMS_EPS)
    return (y * g.astype(jnp.float32)).astype(x.dtype)


def _swiglu(h, w_in, w_out):
    gate, up = jnp.split(h @ w_in, 2, axis=-1)
    return (jax.nn.silu(gate) * up) @ w_out


def _shift_seq(z):
    h = z.shape[-1] // 2
    prev = jnp.pad(z[:, :-1, :h], ((0, 0), (1, 0), (0, 0)))
    nxt = jnp.pad(z[:, 1:, h:], ((0, 0), (0, 1), (0, 0)))
    return jnp.concatenate([prev, nxt], axis=-1)


def _shift_grid(z):
    bsz, length, ch = z.shape
    rows = length // GRID_W
    g = z.reshape(bsz, rows, GRID_W, ch)
    q = ch // 4
    left = jnp.pad(g[:, :, :-1, :q], ((0, 0), (0, 0), (1, 0), (0, 0)))
    right = jnp.pad(g[:, :, 1:, q:2 * q], ((0, 0), (0, 0), (0, 1), (0, 0)))
    up = jnp.pad(g[:, :-1, :, 2 * q:3 * q], ((0, 0), (1, 0), (0, 0), (0, 0)))
    down = jnp.pad(g[:, 1:, :, 3 * q:], ((0, 0), (0, 1), (0, 0), (0, 0)))
    return jnp.concatenate([left, right, up, down], axis=-1).reshape(bsz, length, ch)


def _spatial_gating(zu, zv, ln_g, ln_b, w_s, b_s):
    bsz, length, _ = zu.shape
    u = jax.nn.gelu(zu)
    v = jax.nn.gelu(zv).astype(jnp.float32)
    mu = jnp.mean(v, axis=-1, keepdims=True)
    var = jnp.mean(jnp.square(v - mu), axis=-1, keepdims=True)
    v = ((v - mu) * lax.rsqrt(var + LN_EPS) * ln_g + ln_b).astype(zu.dtype)
    v = v.reshape(bsz, length // CHUNK, CHUNK, A_HEADS, A_WIDTH // A_HEADS)
    mixed = jnp.einsum('hts,bnshd->bnthd', w_s, v) + b_s.T[None, None, :, :, None]
    return u * mixed.reshape(bsz, length, A_WIDTH).astype(zu.dtype)


def _fourier_mix(z):
    bsz, length, _ = z.shape
    zf = z.astype(jnp.float32).reshape(bsz, length, B_GROUPS, B_GROUP_DIM)
    zf = jnp.swapaxes(zf, 1, 2)
    out = jnp.fft.fft2(zf, norm='ortho').real
    return jnp.swapaxes(out, 1, 2).reshape(bsz, length, B_WIDTH).astype(z.dtype)


def _wkv_scan(s0, r, dec, k, v, kk, kka, reverse):
    def step(S, inp):
        r_t, d_t, k_t, v_t, kk_t, kka_t = inp
        sa = jnp.einsum('bhvk,bhk->bhv', S, kk_t)
        S = S * d_t[:, :, None, :] - sa[..., None] * kka_t[:, :, None, :] + v_t[..., None] * k_t[:, :, None, :]
        return S, jnp.einsum('bhvk,bhk->bhv', S, r_t)
    xs = tuple(jnp.swapaxes(t, 0, 1) for t in (r, dec, k, v, kk, kka))
    s_final, ys = lax.scan(step, s0, xs, reverse=reverse)
    return s_final, jnp.swapaxes(ys, 0, 1)


def _rwkv7_bidir(zc, grid, s0, mu, w0, w2, a0, a2, k_k, k_a, r_k, g2, lnx_g, lnx_b):
    bsz, length, _ = zc.shape
    f32 = jnp.float32
    zs = _shift_grid(zc) if grid else _shift_seq(zc)
    z = zc + (zs - zc) * mu
    idx = [C_WIDTH, 2 * C_WIDTH, 3 * C_WIDTH, 3 * C_WIDTH + N_DIR * DECAY_RANK,
           3 * C_WIDTH + N_DIR * (DECAY_RANK + ICLR_RANK)]
    r, k, v, wd, ad, gd = jnp.split(z, idx, axis=-1)
    wd = wd.reshape(bsz, length, N_DIR, DECAY_RANK)
    ad = ad.reshape(bsz, length, N_DIR, ICLR_RANK)
    w_log = -jax.nn.softplus(-(w0 + jnp.einsum('bldr,drc->bldc', jnp.tanh(wd), w2)).astype(f32)) - 0.5
    decay = jnp.exp(-jnp.exp(w_log))
    a = jax.nn.sigmoid((a0 + jnp.einsum('bldr,drc->bldc', ad, a2)).astype(f32))
    kf = k.astype(f32)
    kk = (kf * k_k).reshape(bsz, length, C_HEADS, C_HEAD_DIM)
    kk = kk / jnp.maximum(jnp.sqrt(jnp.sum(kk * kk, axis=-1, keepdims=True)), 1e-12)
    kk = kk.reshape(bsz, length, C_WIDTH)
    k_mod = kf[:, :, None, :] * (1.0 + (a - 1.0) * k_a)

    def heads(t):
        return t.reshape(bsz, length, C_HEADS, C_HEAD_DIM)

    rf = heads(r.astype(f32))
    vf = heads(v.astype(f32))
    s0f = s0.astype(f32)
    s_f, y_f = _wkv_scan(s0f[:, 0], rf, heads(decay[:, :, 0]), heads(k_mod[:, :, 0]), vf,
                         heads(kk), heads(kk * a[:, :, 0]), reverse=False)
    s_b, y_b = _wkv_scan(s0f[:, 1], rf, heads(decay[:, :, 1]), heads(k_mod[:, :, 1]), vf,
                         heads(kk), heads(kk * a[:, :, 1]), reverse=True)
    y = y_f + y_b
    m = jnp.mean(y, axis=-1, keepdims=True)
    var = jnp.mean(jnp.square(y - m), axis=-1, keepdims=True)
    y = ((y - m) * lax.rsqrt(var + LNX_EPS)).reshape(bsz, length, C_WIDTH) * lnx_g + lnx_b
    bonus = jnp.einsum('blhn,bldhn,hn->blh', rf,
                       k_mod.reshape(bsz, length, N_DIR, C_HEADS, C_HEAD_DIM), r_k.astype(f32))
    y = y + (bonus[..., None] * vf).reshape(bsz, length, C_WIDTH)
    g = jax.nn.sigmoid(gd) @ g2
    out = y.astype(zc.dtype) * g
    state = jnp.stack([s_f, s_b], axis=1).astype(s0.dtype)
    return out, state


def _token_mix(h, grid, s0, lp):
    z = h @ lp['w_in']
    zu, zv, zb, zc = jnp.split(z, [A_WIDTH, 2 * A_WIDTH, 2 * A_WIDTH + B_WIDTH], axis=-1)
    ya = _spatial_gating(zu, zv, lp['sgu_ln_g'], lp['sgu_ln_b'], lp['sgu_w'], lp['sgu_b'])
    yb = _fourier_mix(zb)
    yc, state = _rwkv7_bidir(zc, grid, s0, lp['shift_mu'], lp['decay_w0'], lp['decay_w2'],
                             lp['iclr_a0'], lp['iclr_a2'], lp['k_k'], lp['k_a'], lp['r_k'],
                             lp['gate_w2'], lp['lnx_g'], lp['lnx_b'])
    return jnp.concatenate([ya, yb, yc], axis=-1) @ lp['w_out'], state


def _layer(x, cond, s0, grid, lp):
    mod = (jax.nn.silu(cond) @ lp['w_mod'] + lp['b_mod']).reshape(cond.shape[0], 1, N_MOD, D_MODEL)
    norm_g = lp['norm_g']

    def modulated(x_, i):
        return _rmsnorm(x_, norm_g[i]) * (1.0 + mod[:, :, 3 * i + 1]) + mod[:, :, 3 * i]

    x = x + 0.5 * mod[:, :, 2] * _swiglu(modulated(x, 0), lp['ffn_w_in'][0], lp['ffn_w_out'][0])
    y, state = _token_mix(modulated(x, 1), grid, s0, lp)
    x = x + mod[:, :, 5] * y
    x = x + 0.5 * mod[:, :, 8] * _swiglu(modulated(x, 2), lp['ffn_w_in'][1], lp['ffn_w_out'][1])
    return x, state


def setup_inputs(seed: int = 0) -> dict:
    key = jax.random.key(seed)
    ks = jax.random.split(key, 28)
    f32 = jnp.float32
    d = D_MODEL

    def nrm(k, shape, scale):
        return jax.random.normal(k, shape, f32) * scale

    return {
        'x_prompt': nrm(ks[0], (BATCH, SEQ, d), 1.0),
        'x_sample': nrm(ks[1], (DEC_BATCH, DEC_SEQ, d), 1.0),
        'state_wkv': nrm(ks[2], (DEC_BATCH, DEPTH, N_DIR, C_HEADS, C_HEAD_DIM, C_HEAD_DIM), 0.5),
        'c': nrm(ks[3], (DEC_BATCH, d), 1.0),
        'c_ctx': nrm(ks[4], (d,), 1.0),
        'norm_g': 1.0 + nrm(ks[5], (DEPTH, 3, d), 0.02),
        'w_mod': nrm(ks[6], (DEPTH, d, N_MOD * d), 0.5 * d ** -0.5),
        'b_mod': nrm(ks[7], (DEPTH, N_MOD * d), 0.02),
        'ffn_w_in': nrm(ks[8], (DEPTH, 2, d, 2 * D_FF), d ** -0.5),
        'ffn_w_out': nrm(ks[9], (DEPTH, 2, D_FF, d), D_FF ** -0.5),
        'w_in': nrm(ks[10], (DEPTH, d, IN_COLS), d ** -0.5),
        'w_out': nrm(ks[11], (DEPTH, MIX_WIDTH, d), MIX_WIDTH ** -0.5),
        'sgu_ln_g': 1.0 + nrm(ks[12], (DEPTH, A_WIDTH), 0.02),
        'sgu_ln_b': nrm(ks[13], (DEPTH, A_WIDTH), 0.02),
        'sgu_w': nrm(ks[14], (DEPTH, A_HEADS, CHUNK, CHUNK), CHUNK ** -0.5),
        'sgu_b': 1.0 + nrm(ks[15], (DEPTH, A_HEADS, CHUNK), 0.1),
        'shift_mu': jax.random.uniform(ks[16], (DEPTH, C_IN), f32, 0.2, 0.8),
        'decay_w0': nrm(ks[17], (DEPTH, N_DIR, C_WIDTH), 0.5),
        'decay_w2': nrm(ks[18], (DEPTH, N_DIR, DECAY_RANK, C_WIDTH), 0.5 * DECAY_RANK ** -0.5),
        'iclr_a0': nrm(ks[19], (DEPTH, N_DIR, C_WIDTH), 0.1),
        'iclr_a2': nrm(ks[20], (DEPTH, N_DIR, ICLR_RANK, C_WIDTH), ICLR_RANK ** -0.5),
        'k_k': 0.85 + nrm(ks[21], (DEPTH, C_WIDTH), 0.05),
        'k_a': 1.0 + nrm(ks[22], (DEPTH, C_WIDTH), 0.05),
        'r_k': nrm(ks[23], (DEPTH, C_HEADS, C_HEAD_DIM), 0.1),
        'gate_w2': nrm(ks[24], (DEPTH, GATE_RANK, C_WIDTH), GATE_RANK ** -0.5),
        'lnx_g': 1.0 + nrm(ks[25], (DEPTH, C_WIDTH), 0.02),
        'lnx_b': nrm(ks[26], (DEPTH, C_WIDTH), 0.02),
        'final_g': 1.0 + nrm(ks[27], (d,), 0.02),
    }


def reference(x_prompt, x_sample, state_wkv, c, c_ctx, norm_g, w_mod, b_mod, ffn_w_in, ffn_w_out,
              w_in, w_out, sgu_ln_g, sgu_ln_b, sgu_w, sgu_b, shift_mu, decay_w0, decay_w2,
              iclr_a0, iclr_a2, k_k, k_a, r_k, gate_w2, lnx_g, lnx_b, final_g):
    xp = x_prompt
    xs = x_sample
    zero_state = jnp.zeros((x_prompt.shape[0], N_DIR, C_HEADS, C_HEAD_DIM, C_HEAD_DIM), x_prompt.dtype)
    ctx_cond = c_ctx[None, :]
    ctx_states = []
    for l in range(DEPTH):
        lp = {
            'norm_g': norm_g[l], 'w_mod': w_mod[l], 'b_mod': b_mod[l],
            'ffn_w_in': ffn_w_in[l], 'ffn_w_out': ffn_w_out[l],
            'w_in': w_in[l], 'w_out': w_out[l],
            'sgu_ln_g': sgu_ln_g[l], 'sgu_ln_b': sgu_ln_b[l], 'sgu_w': sgu_w[l], 'sgu_b': sgu_b[l],
            'shift_mu': shift_mu[l], 'decay_w0': decay_w0[l], 'decay_w2': decay_w2[l],
            'iclr_a0': iclr_a0[l], 'iclr_a2': iclr_a2[l], 'k_k': k_k[l], 'k_a': k_a[l],
            'r_k': r_k[l], 'gate_w2': gate_w2[l], 'lnx_g': lnx_g[l], 'lnx_b': lnx_b[l],
        }
        xp, s_ctx = _layer(xp, ctx_cond, zero_state, False, lp)
        ctx_states.append(s_ctx)
        xs, _ = _layer(xs, c, state_wkv[:, l], True, lp)
    y_prompt = _rmsnorm(xp, final_g)
    y_sample = _rmsnorm(xs, final_g)
    new_state_wkv = jnp.stack(ctx_states, axis=1)
    return (y_prompt, y_sample, new_state_wkv)
```

```cpp
#include <hip/hip_runtime.h>
#include <cstdio>
#include <cstdint>

#ifndef SCAN_CHUNKED
#define SCAN_CHUNKED 1
#endif
#ifndef LATPIPE
#define LATPIPE true
#endif
#ifndef DBG_VMW
#define DBG_VMW 21
#endif
#ifndef DBG_AFTER_WAIT
#define DBG_AFTER_WAIT
#endif
#ifndef DBG_DUP_Q
#define DBG_DUP_Q 1
#endif
#ifndef DBG_DUP_SEL
#define DBG_DUP_SEL 15
#endif
#ifndef LAT_SOLO
#define LAT_SOLO 0
#endif
#ifndef FNET_IN_POST
#define FNET_IN_POST 0
#endif
#ifndef GEMM_ALIGN
#define GEMM_ALIGN true
#endif
#ifndef GEMM_SP2
#define GEMM_SP2 true
#endif
#ifndef LAT_PRIO
#define LAT_PRIO 3
#endif
#ifndef DBG_P6A
#define DBG_P6A 1
#endif
#ifndef DBG_P6B
#define DBG_P6B 1
#endif
#ifndef DBG_P6R
#define DBG_P6R 1
#endif
#ifndef DBG_P6L
#define DBG_P6L 1
#endif
#ifndef ONE_LAUNCH
#define ONE_LAUNCH 1
#endif

namespace pg8 {
#define PG8_LAS __attribute__((address_space(3)))
typedef unsigned short bf16_t;
typedef short bf16x8 __attribute__((ext_vector_type(8)));
typedef float f32x4 __attribute__((ext_vector_type(4)));
typedef unsigned u32x4 __attribute__((ext_vector_type(4)));
constexpr int BM = 256, BK = 64, HALF = 128, HTB = HALF * BK * 2  , STAGE_BYTES = 8 * HTB, NXCD = 8, WGM = 8;

__host__ __device__ __forceinline__ int lds_byte(int r, int c) { const int st = (r >> 4) * 2 + (c >> 5), rr = r & 15, cc = c & 31, ob = rr * 64 + cc * 2; return st * 1024 + (ob ^ (((ob >> 9) & 1) << 5)); }
__host__ __device__ __forceinline__ void stage_rc(int b, int& R, int& C) { const int st = b / 1024, sb = b % 1024, swz = sb ^ (((sb >> 9) & 1) << 5); R = (st >> 1) * 16 + swz / 64; C = (st & 1) * 32 + (swz % 64) / 2; }
__host__ __device__ __forceinline__ int perm32(int rho) { const int n = rho >> 4, i = rho & 15; return 8 * (i >> 2) + 4 * n + (i & 3); }

__host__ __device__ __forceinline__ size_t blk_off(int row, int k, int K) { const int ob = (row & 15) * 64 + (k & 31) * 2; return ((size_t)(row >> 4) * (K >> 5) + (k >> 5)) * 512 + ((ob ^ (((ob >> 9) & 1) << 5)) >> 1); }
struct Unit { int pm, pn; };
struct Gemm { const bf16_t* A; const bf16_t* Bt; int M, N, K; };

struct StaticOrder {
    int nM, nN, nwg, G, c;
    __host__ __device__ void init(int M, int N, int G_, int c_) { nM = M / BM; nN = N / BM; nwg = nM * nN; G = G_; c = c_; }
    __host__ __device__ bool next(int i, Unit& u) const {
        const long L = (long)i * G + c; if (L >= nwg) return false;
        int wgid = (int)L; { const int q = nwg / NXCD, r = nwg % NXCD, xcd = wgid % NXCD, off = wgid / NXCD; wgid = (xcd < r ? xcd * (q + 1) : r * (q + 1) + (xcd - r) * q) + off; }
        const int nig = WGM * nN, gid = wgid / nig, fm = gid * WGM, gsz = (nM - fm) < WGM ? (nM - fm) : WGM;
        u.pm = fm + ((wgid % nig) % gsz); u.pn = (wgid % nig) / gsz; return true;
    }
    __device__ __forceinline__ void a_ready(const Unit&) const {}
    __device__ __forceinline__ void done(const Unit&) const {}
};
template <bool TAIL> struct SplitOrder {
    StaticOrder b; int nfull;
    __host__ __device__ void init(int M, int N, int G_, int c_) { b.init(M, N, G_, c_); nfull = (b.nwg / G_) * G_; }
    __host__ __device__ bool next(int i, Unit& u) const {
        if (!TAIL) { const long L = (long)i * b.G + b.c; if (L >= nfull) return false; return b.next(i, u); }
        const long h = (long)i * b.G + b.c; if (h >= 2L * (b.nwg - nfull)) return false;
        StaticOrder t = b; const int big = nfull + (int)(h >> 1); t.c = big % b.G; Unit v; t.next(big / b.G, v);
        u.pm = 2 * v.pm + (int)(h & 1); u.pn = v.pn; return true;
    }
    __device__ __forceinline__ void a_ready(const Unit&) const {}
    __device__ __forceinline__ void done(const Unit&) const {}
};

typedef unsigned u32x2v __attribute__((ext_vector_type(2)));
typedef float f32x2p __attribute__((ext_vector_type(2))); typedef __bf16 bf16x2p __attribute__((ext_vector_type(2)));
__device__ __forceinline__ unsigned cvt_pk_bf16(float lo, float hi) { const f32x2p v = {lo, hi}; const bf16x2p b = __builtin_convertvector(v, bf16x2p); return __builtin_bit_cast(unsigned, b); }
__device__ __forceinline__ float fsilu(float x) { return x * __builtin_amdgcn_rcpf(1.0f + __expf(-x)); }

struct EpiF32 {
    static constexpr bool PERM = false, AFTER_DRAIN = false;
    float* C; int ldc;
    __device__ __forceinline__ void operator()(const f32x4 (&acc)[2][2][4][2], const Unit& u, int wr, int wc, int fr, int fq) const {
        const int row0 = u.pm * BM + wr * 64 + fr, col0 = u.pn * BM + wc * 32 + 4 * fq;
#pragma unroll
        for (int ai = 0; ai < 2; ++ai)
#pragma unroll
            for (int m = 0; m < 4; ++m) { float* rowp = C + (size_t)(row0 + ai * HALF + m * 16) * ldc + col0;
#pragma unroll
                for (int bj = 0; bj < 2; ++bj)
#pragma unroll
                    for (int n = 0; n < 2; ++n) *(f32x4*)(rowp + bj * HALF + n * 16) = acc[ai][bj][m][n]; }
    }
};
template <int MF> struct EpiBf16 {
    static constexpr bool PERM = true, AFTER_DRAIN = false;
    bf16_t* O; int ldo;
    __device__ __forceinline__ void operator()(const f32x4 (&acc)[2][2][MF][2], const Unit& u, int wr, int wc, int fr, int fq) const {
        const int row0 = u.pm * (64 * MF) + wr * (16 * MF) + fr, col0 = u.pn * BM + wc * 32 + 8 * fq;
#pragma unroll
        for (int ai = 0; ai < 2; ++ai)
#pragma unroll
            for (int m = 0; m < MF; ++m) { bf16_t* rowp = O + (size_t)(row0 + ai * (32 * MF) + m * 16) * ldo + col0;
#pragma unroll
                for (int bj = 0; bj < 2; ++bj) { const f32x4 v0 = acc[ai][bj][m][0], v1 = acc[ai][bj][m][1];
                    u32x4 w; w.x = cvt_pk_bf16(v0[0], v0[1]); w.y = cvt_pk_bf16(v0[2], v0[3]); w.z = cvt_pk_bf16(v1[0], v1[1]); w.w = cvt_pk_bf16(v1[2], v1[3]);
                    *(u32x4*)(rowp + bj * HALF) = w; } }
    }
};
template <int MF> struct EpiSwiGLU {
    static constexpr bool PERM = true, AFTER_DRAIN = false;
    bf16_t* O; int ldo;
    __device__ __forceinline__ void operator()(const f32x4 (&acc)[2][2][MF][2], const Unit& u, int wr, int wc, int fr, int fq) const {
        const int row0 = u.pm * (64 * MF) + wr * (16 * MF) + fr, col0 = u.pn * HALF + wc * 32 + 8 * fq;
#pragma unroll
        for (int ai = 0; ai < 2; ++ai)
#pragma unroll
            for (int m = 0; m < MF; ++m) {
                const f32x4 g0 = acc[ai][0][m][0], g1 = acc[ai][0][m][1], u0 = acc[ai][1][m][0], u1 = acc[ai][1][m][1];
                u32x4 w;
                w.x = cvt_pk_bf16(fsilu(g0[0]) * u0[0], fsilu(g0[1]) * u0[1]); w.y = cvt_pk_bf16(fsilu(g0[2]) * u0[2], fsilu(g0[3]) * u0[3]);
                w.z = cvt_pk_bf16(fsilu(g1[0]) * u1[0], fsilu(g1[1]) * u1[1]); w.w = cvt_pk_bf16(fsilu(g1[2]) * u1[2], fsilu(g1[3]) * u1[3]);
                *(u32x4*)(O + blk_off(row0 + ai * (32 * MF) + m * 16, col0, ldo)) = w;
            }
    }
};
template <int MF, bool XF32IN> struct EpiResid {
    static constexpr bool PERM = true, AFTER_DRAIN = false;
    const void* xin_c; const void* xin_l; bf16_t* X; const float* modf; int jchunk; float coef;
    __device__ __forceinline__ void operator()(const f32x4 (&acc)[2][2][MF][2], const Unit& u, int wr, int wc, int fr, int fq) const {
        const int col0 = u.pn * BM + wc * 32 + 8 * fq;
#pragma unroll
        for (int ai = 0; ai < 2; ++ai)
#pragma unroll
            for (int m = 0; m < MF; ++m) {
                const int row = u.pm * (64 * MF) + ai * (32 * MF) + wr * (16 * MF) + m * 16 + fr;
                const int c = row < 8192 ? 0 : 1 + ((row - 8192) >> 10);
                const int row_in = row < 8192 ? row : row - 8192;
                const size_t xo_in = (size_t)row_in * 2048 + col0;
                const void* xb = row < 8192 ? xin_c : xin_l;

                const float* gp = modf + (size_t)c * 18432 + jchunk * 2048 + col0;
#pragma unroll
                for (int bj = 0; bj < 2; ++bj) {
                    f32x4 x0, x1;
                    if constexpr (XF32IN) { x0 = *(const f32x4*)((const float*)xb + xo_in + bj * HALF); x1 = *(const f32x4*)((const float*)xb + xo_in + bj * HALF + 4); }
                    else { const u32x4 w = *(const u32x4*)((const bf16_t*)xb + blk_off(row_in, col0 + bj * HALF, 2048));
                           x0 = (f32x4){__uint_as_float(w.x << 16), __uint_as_float(w.x & 0xffff0000u), __uint_as_float(w.y << 16), __uint_as_float(w.y & 0xffff0000u)};
                           x1 = (f32x4){__uint_as_float(w.z << 16), __uint_as_float(w.z & 0xffff0000u), __uint_as_float(w.w << 16), __uint_as_float(w.w & 0xffff0000u)}; }
                    const f32x4 g0 = *(const f32x4*)(gp + bj * HALF), g1 = *(const f32x4*)(gp + bj * HALF + 4);
                    const f32x4 o0 = x0 + (g0 * coef) * acc[ai][bj][m][0], o1 = x1 + (g1 * coef) * acc[ai][bj][m][1];
                    u32x4 wo; wo.x = cvt_pk_bf16(o0[0], o0[1]); wo.y = cvt_pk_bf16(o0[2], o0[3]); wo.z = cvt_pk_bf16(o1[0], o1[1]); wo.w = cvt_pk_bf16(o1[2], o1[3]);
                    *(u32x4*)(X + blk_off(row, col0 + bj * HALF, 2048)) = wo; }
            }
    }
};

template <class Epi, class Sched, bool ALIGN_EPI = false, bool SP2 = false, int MF = 4>
__device__ __forceinline__ void gemm_phase(PG8_LAS unsigned char* lds, const Gemm g, const Sched& S, const Epi& E) {
    int tid_ = threadIdx.x; asm volatile("" : "+v"(tid_));
    const int tid = tid_, wid = __builtin_amdgcn_readfirstlane(tid >> 6), lane = tid & 63, wr = wid >> 2, wc = wid & 3, fr = lane & 15, fq = lane >> 4;
    const int K = g.K, nt = K / BK;
    unsigned voffA[2], voffB[2];
#pragma unroll
    for (int i = 0; i < 2; ++i) { int R, C; stage_rc(tid * 16 + i * 8192, R, C); const int Rb = Epi::PERM ? ((R & ~31) + perm32(R & 31)) : R;
        const int Ra = (R >= 32 * MF) ? R - (128 - 32 * MF) : R;
        (void)Ra; (void)Rb;
        { const int st = wid + 8 * i, br = (st >> 1) < 2 * MF ? (st >> 1) : (st >> 1) - (8 - 2 * MF); voffA[i] = (unsigned)((br * (K >> 5) + (st & 1)) * 1024 + lane * 16); }
        { const int st = wid + 8 * i; voffB[i] = (unsigned)(((st >> 1) * (K >> 5) + (st & 1)) * 1024 + lane * 16); } }
    const size_t kstepA = 2048, kstepB = 2048;
    const size_t hstepB = (size_t)HALF * K * 2, tstepB = 2 * hstepB;
    const size_t hstepA = (size_t)(32 * MF) * K * 2, tstepA = 2 * hstepA;
    const unsigned ldsw = (unsigned)wid * 1024u;
    const int aoff = lds_byte(wr * (16 * MF) + fr, fq * 8), boff = lds_byte(wc * 32 + fr, fq * 8);
#define PG8_SA(b, h) (((b) * 2 + (h)) * HTB)
#define PG8_SB(b, h) ((4 + (b) * 2 + (h)) * HTB)
#define PG8_STAGE(bufoff, gbase, voff) do { _Pragma("unroll") for (int _i = 0; _i < 2; ++_i) \
        __builtin_amdgcn_global_load_lds((const unsigned*)((const char*)(gbase) + (voff)[_i]), (PG8_LAS unsigned*)(lds + (bufoff) + ldsw + _i * 8192), 16, 0, 0); } while (0)
#define PG8_LDA(dst, b, h) do { _Pragma("unroll") for (int m = 0; m < MF; ++m) _Pragma("unroll") for (int k = 0; k < 2; ++k) dst[m][k] = *(const PG8_LAS bf16x8*)(lds + PG8_SA(b, h) + aoff + m * 2048 + k * 1024); } while (0)
#define PG8_LDB(dst, b, h) do { _Pragma("unroll") for (int n = 0; n < 2; ++n) _Pragma("unroll") for (int k = 0; k < 2; ++k) dst[n][k] = *(const PG8_LAS bf16x8*)(lds + PG8_SB(b, h) + boff + n * 2048 + k * 1024); } while (0)
#define PG8_MMA(ai, bj, At, Bt) do { __builtin_amdgcn_s_setprio(1); _Pragma("unroll") for (int m = 0; m < MF; ++m) _Pragma("unroll") for (int n = 0; n < 2; ++n) _Pragma("unroll") for (int k = 0; k < 2; ++k) \
        acc[ai][bj][m][n] = __builtin_amdgcn_mfma_f32_16x16x32_bf16(Bt[n][k], At[m][k], acc[ai][bj][m][n], 0, 0, 0); __builtin_amdgcn_s_setprio(0); } while (0)
#define PG8_WAIT_V(n) asm volatile("s_waitcnt vmcnt(" #n ")" ::: "memory")
#define PG8_WAIT_L(n) asm volatile("s_waitcnt lgkmcnt(" #n ")" ::: "memory")
#define PG8_BAR __builtin_amdgcn_s_barrier()
#define PG8_SCHED __builtin_amdgcn_sched_barrier(0)
    Unit cur, nxt; int ui = 0;
    if (!S.next(0, cur)) return;
    f32x4 acc[2][2][MF][2];
#pragma unroll
    for (int a = 0; a < 2; ++a)
#pragma unroll
        for (int b = 0; b < 2; ++b)
#pragma unroll
            for (int m = 0; m < MF; ++m)
#pragma unroll
                for (int n = 0; n < 2; ++n) acc[a][b][m][n] = (f32x4){0.f, 0.f, 0.f, 0.f};
    bf16x8 At[MF][2], B0[2][2], B1[2][2];
    const char* cA = (const char*)g.A + (size_t)cur.pm * tstepA; const char* cB = (const char*)g.Bt + (size_t)cur.pn * tstepB;
    S.a_ready(cur);
    if constexpr (SP2) {
        PG8_STAGE(PG8_SB(0, 0), cB, voffB); PG8_STAGE(PG8_SB(0, 1), cB + hstepB, voffB); PG8_STAGE(PG8_SA(0, 0), cA, voffA); PG8_STAGE(PG8_SA(0, 1), cA + hstepA, voffA);
        if (wr == 1) PG8_BAR;
        PG8_WAIT_V(2); PG8_BAR;
        PG8_STAGE(PG8_SB(1, 0), cB + kstepB, voffB); PG8_STAGE(PG8_SA(1, 0), cA + kstepA, voffA); PG8_STAGE(PG8_SB(1, 1), cB + hstepB + kstepB, voffB);
        PG8_WAIT_V(6); PG8_BAR;
    } else {
        PG8_STAGE(PG8_SB(0, 0), cB, voffB); PG8_STAGE(PG8_SA(0, 0), cA, voffA); PG8_STAGE(PG8_SB(0, 1), cB + hstepB, voffB); PG8_STAGE(PG8_SA(0, 1), cA + hstepA, voffA);
        if (wr == 1) PG8_BAR;
        PG8_WAIT_V(4); PG8_BAR;
        PG8_STAGE(PG8_SB(1, 0), cB + kstepB, voffB); PG8_STAGE(PG8_SA(1, 0), cA + kstepA, voffA); PG8_STAGE(PG8_SB(1, 1), cB + hstepB + kstepB, voffB);
        PG8_WAIT_V(6); PG8_BAR;
    }
    for (;;) {
        const bool has_next = S.next(ui + 1, nxt);
        const char* nA = has_next ? (const char*)g.A + (size_t)nxt.pm * tstepA : cA; const char* nB = has_next ? (const char*)g.Bt + (size_t)nxt.pn * tstepB : cB;
        for (int t = 0; t < nt; t += 2) {
            const bool last = (t == nt - 2);
            const char* a1 = cA + (size_t)(t + 1) * kstepA;
            const char* a2 = last ? nA : cA + (size_t)(t + 2) * kstepA; const char* b2 = last ? nB : cB + (size_t)(t + 2) * kstepB;
            const char* a3 = a2 + kstepA; const char* b3 = b2 + kstepB;
            if (last && has_next) S.a_ready(nxt);
            if constexpr (SP2) {
            PG8_LDB(B0, 0, 0); PG8_LDB(B1, 0, 1); PG8_SCHED; PG8_LDA(At, 0, 0); PG8_STAGE(PG8_SA(1, 1), a1 + hstepA, voffA);
            PG8_WAIT_V(8); PG8_WAIT_L(0); PG8_BAR; PG8_MMA(0, 0, At, B0); PG8_MMA(0, 1, At, B1); PG8_BAR; PG8_SCHED;
            PG8_LDA(At, 0, 1); PG8_STAGE(PG8_SB(0, 0), b2, voffB); PG8_STAGE(PG8_SB(0, 1), b2 + hstepB, voffB); PG8_STAGE(PG8_SA(0, 0), a2, voffA);
            PG8_WAIT_V(8); PG8_WAIT_L(0); PG8_BAR; PG8_MMA(1, 0, At, B0); PG8_MMA(1, 1, At, B1); PG8_BAR; PG8_SCHED;
            PG8_LDB(B0, 1, 0); PG8_LDB(B1, 1, 1); PG8_SCHED; PG8_LDA(At, 1, 0); PG8_STAGE(PG8_SA(0, 1), a2 + hstepA, voffA);
            PG8_WAIT_V(8); PG8_WAIT_L(0); PG8_BAR; PG8_MMA(0, 0, At, B0); PG8_MMA(0, 1, At, B1); PG8_BAR; PG8_SCHED;
            PG8_LDA(At, 1, 1); PG8_STAGE(PG8_SB(1, 0), b3, voffB); PG8_STAGE(PG8_SB(1, 1), b3 + hstepB, voffB); PG8_STAGE(PG8_SA(1, 0), a3, voffA);
            PG8_WAIT_V(8); PG8_WAIT_L(0); PG8_BAR; PG8_MMA(1, 0, At, B0); PG8_MMA(1, 1, At, B1); PG8_BAR; PG8_SCHED;
            } else {
            PG8_LDB(B0, 0, 0); PG8_SCHED; PG8_LDA(At, 0, 0); PG8_STAGE(PG8_SA(1, 1), a1 + hstepA, voffA);
            PG8_WAIT_L(8); PG8_BAR; PG8_WAIT_L(0); PG8_MMA(0, 0, At, B0); PG8_BAR; PG8_SCHED;
            PG8_LDB(B1, 0, 1); PG8_STAGE(PG8_SB(0, 0), b2, voffB);
            PG8_BAR; PG8_WAIT_L(0); PG8_MMA(0, 1, At, B1); PG8_BAR;
            PG8_LDA(At, 0, 1); PG8_STAGE(PG8_SA(0, 0), a2, voffA);
            PG8_BAR; PG8_WAIT_L(0); PG8_MMA(1, 0, At, B0); PG8_BAR; PG8_SCHED;
            PG8_STAGE(PG8_SB(0, 1), b2 + hstepB, voffB);
            PG8_WAIT_V(6); PG8_BAR; PG8_MMA(1, 1, At, B1); PG8_BAR;
            PG8_LDB(B0, 1, 0); PG8_SCHED; PG8_LDA(At, 1, 0); PG8_STAGE(PG8_SA(0, 1), a2 + hstepA, voffA);
            PG8_WAIT_L(8); PG8_BAR; PG8_WAIT_L(0); PG8_MMA(0, 0, At, B0); PG8_BAR; PG8_SCHED;
            PG8_LDB(B1, 1, 1); PG8_STAGE(PG8_SB(1, 0), b3, voffB);
            PG8_BAR; PG8_WAIT_L(0); PG8_MMA(0, 1, At, B1); PG8_BAR;
            PG8_LDA(At, 1, 1); PG8_STAGE(PG8_SA(1, 0), a3, voffA);
            PG8_BAR; PG8_WAIT_L(0); PG8_MMA(1, 0, At, B0); PG8_BAR; PG8_SCHED;
            PG8_STAGE(PG8_SB(1, 1), b3 + hstepB, voffB);
            PG8_WAIT_V(6); PG8_BAR; PG8_MMA(1, 1, At, B1); PG8_BAR;
            }
        }
        if constexpr (ALIGN_EPI) { if (wr == 0) PG8_BAR; }
        if constexpr (!Epi::AFTER_DRAIN) { E(acc, cur, wr, wc, fr, fq); S.done(cur); }
        if (!has_next) break;
#pragma unroll
        for (int a = 0; a < 2; ++a)
#pragma unroll
            for (int b = 0; b < 2; ++b)
#pragma unroll
                for (int m = 0; m < MF; ++m)
#pragma unroll
                    for (int n = 0; n < 2; ++n) acc[a][b][m][n] = (f32x4){0.f, 0.f, 0.f, 0.f};
        cur = nxt; cA = nA; cB = nB; ++ui;
        if constexpr (ALIGN_EPI) { if (wr == 1) PG8_BAR; }
    }
    PG8_WAIT_V(0);
    if constexpr (!ALIGN_EPI) { if (wr == 0) PG8_BAR; }
    PG8_BAR;
    if constexpr (Epi::AFTER_DRAIN) { E.fused(acc, cur, wr, wc, fr, fq, lds, wid, lane); S.done(cur); }
#undef PG8_SA
#undef PG8_SB
#undef PG8_STAGE
#undef PG8_LDA
#undef PG8_LDB
#undef PG8_MMA
#undef PG8_WAIT_V
#undef PG8_WAIT_L
#undef PG8_BAR
#undef PG8_SCHED
}
}

#define XB_TMO      128
#define XB_XCNT(j)  (256  + 64 * (j))
#define XB_XSUB(j)  (1280 + 64 * (j))
#define XB_XGEN(j)  (2304 + 64 * (j))
#define XB_TOP      3328
#define XB_TOPGEN   3392
#define XCD_BAR_WORDS 3456
#define XB_SPIN_CAP (1u << 18)
#define LAS __attribute__((address_space(3)))

__device__ __forceinline__ unsigned xb_ld(unsigned* p)              { return __hip_atomic_load(p, __ATOMIC_RELAXED, __HIP_MEMORY_SCOPE_AGENT); }
__device__ __forceinline__ unsigned xb_add(unsigned* p, unsigned v) { return __hip_atomic_fetch_add(p, v, __ATOMIC_RELAXED, __HIP_MEMORY_SCOPE_AGENT); }
__device__ __forceinline__ unsigned xb_xcc_id() { return (unsigned)__builtin_amdgcn_s_getreg((3 << 11) | 20) & 0xFu; }
#define XB_SPIN(cond, bar) do { unsigned _sp = 0; while (cond) { __builtin_amdgcn_s_sleep(1); \
    if ((++_sp & 255u) == 0u) { if (xb_ld(&(bar)[XB_TMO])) break; if (_sp > XB_SPIN_CAP) { atomicAdd(&(bar)[XB_TMO], 1u); break; } } } } while (0)

struct XcdBarrier {
    unsigned* bar; unsigned x;
    volatile LAS unsigned* st;
};

__device__ __forceinline__ XcdBarrier xcd_barrier_post(unsigned* bar, volatile LAS unsigned* st) {
    XcdBarrier b; b.bar = bar; b.x = xb_xcc_id(); b.st = st;
    if (threadIdx.x == 0) (void)xb_add(&bar[XB_XCNT(b.x)], 1u);
    return b;
}
__device__ __forceinline__ void xcd_barrier_complete(unsigned* bar, unsigned x, unsigned& nloc, unsigned& nx) {
    const unsigned G = gridDim.x * gridDim.y * gridDim.z;
    unsigned sum, cnt, mine, sp = 0u;
    for (;;) {
        sum = 0u; cnt = 0u; mine = 0u;
#pragma unroll
        for (unsigned j = 0; j < 16; ++j) { const unsigned c = xb_ld(&bar[XB_XCNT(j)]); sum += c; cnt += (c > 0u) ? 1u : 0u; mine = (j == x) ? c : mine; }
        if (sum == G) break;
        __builtin_amdgcn_s_sleep(1);
        if ((++sp & 255u) == 0u) { if (xb_ld(&bar[XB_TMO])) break; if (sp > XB_SPIN_CAP) { atomicAdd(&bar[XB_TMO], 1u); break; } }
    }
    nloc = mine > 0u ? mine : 1u; nx = cnt > 0u ? cnt : 1u;
}

__device__ __forceinline__ void xcd_barrier(const XcdBarrier& b) {
    asm volatile("s_waitcnt vmcnt(0)" ::: "memory");
    __syncthreads();
    if (threadIdx.x == 0) {
        unsigned* bar = b.bar;
        __builtin_amdgcn_s_waitcnt(0);
        unsigned nloc = b.st[0], nx = b.st[1];
        if (nloc == 0u) { xcd_barrier_complete(bar, b.x, nloc, nx); b.st[0] = nloc; b.st[1] = nx; }
        const unsigned old = xb_add(&bar[XB_XSUB(b.x)], 1u);
        const unsigned gen = old / nloc;
        if (old + 1u == (gen + 1u) * nloc) {
            __builtin_amdgcn_fence(__ATOMIC_RELEASE, "agent");
            asm volatile("s_waitcnt vmcnt(0)" ::: "memory");
            const unsigned og = xb_add(&bar[XB_TOP], 1u);
            const unsigned tg = og / nx;
            if (og + 1u == (tg + 1u) * nx) xb_add(&bar[XB_TOPGEN], 1u);
            else XB_SPIN(xb_ld(&bar[XB_TOPGEN]) == tg, bar);
            __builtin_amdgcn_fence(__ATOMIC_ACQUIRE, "agent");
            xb_add(&bar[XB_XGEN(b.x)], 1u);
            asm volatile("s_waitcnt vmcnt(0)" ::: "memory");
        } else {
            XB_SPIN(xb_ld(&bar[XB_XGEN(b.x)]) == gen, bar);
            __builtin_amdgcn_fence(__ATOMIC_ACQUIRE, "agent");
            asm volatile("s_waitcnt vmcnt(0)" ::: "memory");
        }
    }
    __syncthreads();
}


#define LAS __attribute__((address_space(3)))
typedef unsigned short bf16_t;
typedef short bf16x8 __attribute__((ext_vector_type(8)));
typedef float f32x4 __attribute__((ext_vector_type(4)));
typedef float f32x2 __attribute__((ext_vector_type(2)));
typedef unsigned u32x4 __attribute__((ext_vector_type(4)));
typedef unsigned u32x2 __attribute__((ext_vector_type(2)));

constexpr int D = 2048, MC = 8192, ML = 4096, M = MC + ML, DFF = 5632, NFF = 2 * DFF, NIN = 5024, NINP = 5120, CW = 1024;
constexpr int ZC0 = 1536, CIN = 3488, NMOD = 18432;
constexpr int NWAVES = 8, NTHR = 512;
constexpr int LDS_BYTES = 159744;
constexpr int LDS_MISC = 155136;

constexpr size_t al256(size_t x) { return (x + 255) & ~(size_t)255; }
constexpr size_t WS_CTL = 0;
constexpr size_t CTL_BYTES = 32768;
constexpr size_t WS_MODP = WS_CTL + CTL_BYTES;
constexpr size_t WS_MODF = al256(WS_MODP + (size_t)2 * 4 * 5 * NMOD * 4);
constexpr size_t WS_W2T = al256(WS_MODF + (size_t)2 * 5 * NMOD * 4);
constexpr size_t WS_A2T = WS_W2T + (size_t)2 * 2 * 1024 * 64 * 2;
constexpr size_t WS_G2T = WS_A2T + (size_t)2 * 2 * 1024 * 64 * 2;
constexpr size_t WS_SGUW = al256(WS_G2T + (size_t)2 * 1024 * 160 * 2);
constexpr size_t WS_CS128 = WS_SGUW + (size_t)2 * 4 * 128 * 128 * 2;
constexpr size_t WS_DFTL = WS_CS128 + (size_t)256 * 128 * 2;
constexpr size_t WS_DFTC = WS_DFTL + (size_t)1024 * 2048 * 2;
constexpr size_t WS_WFFI = al256(WS_DFTC + (size_t)256 * 512 * 2);
constexpr size_t WS_WFFO = WS_WFFI + (size_t)4 * NFF * D * 2;
constexpr size_t WS_WIN = WS_WFFO + (size_t)4 * D * DFF * 2;
constexpr size_t WS_WOUT = WS_WIN + (size_t)2 * NINP * D * 2;
constexpr size_t WS_X = WS_WOUT + (size_t)2 * D * D * 2;
constexpr size_t WS_H = WS_X + (size_t)M * D * 4;
constexpr size_t WS_Z = WS_H + (size_t)M * D * 2;
constexpr size_t WS_SC = WS_Z + (size_t)M * NINP * 4;
constexpr size_t SC_ARR = (size_t)M * CW * 4;
constexpr size_t WS_G = WS_SC + 7 * SC_ARR;
constexpr size_t WS_INVN = WS_G + (size_t)M * CW * 2;
constexpr size_t WS_U = WS_INVN + (size_t)M * 16 * 4;
constexpr size_t WS_VNT = WS_U + (size_t)M * 512 * 2;
constexpr size_t WS_TTB = WS_VNT + (size_t)M * 512 * 2;
constexpr size_t WS_TW = WS_TTB + (size_t)M * 512 * 2 * 2;
constexpr size_t WS_AD = WS_TW + (size_t)M * 128 * 2;
constexpr size_t WS_GS = WS_AD + (size_t)M * 128 * 2;
constexpr size_t WS_END = WS_GS + (size_t)M * 160 * 2;
static_assert(WS_END <= (size_t)1207959552, "workspace must fit 4 x the largest input");
static_assert((size_t)M * DFF * 2 <= (size_t)M * NINP * 4 && 2 * SC_ARR <= (size_t)M * NINP * 4, "overlays fit in Z");

constexpr int CW_BAR = 0;
constexpr int CW_JOB = 4096;
constexpr int CW_SPLITK = 6144;

__host__ __device__ __forceinline__ size_t frag_addr(int row, int k, int K2) { return ((size_t)(row >> 4) * (K2 >> 5) + (k >> 5)) * 512 + ((row & 15) + 16 * ((k & 31) >> 3)) * 8 + (k & 7); }
struct Params {
    const float *x_prompt, *x_sample, *state_wkv, *c, *c_ctx, *norm_g, *w_mod, *b_mod, *ffn_w_in, *ffn_w_out, *w_in, *w_out, *sgu_ln_g, *sgu_ln_b, *sgu_w, *sgu_b,
                *shift_mu, *decay_w0, *decay_w2, *iclr_a0, *iclr_a2, *k_k, *k_a, *r_k, *gate_w2, *lnx_g, *lnx_b, *final_g;
    float* out; unsigned char* ws; int ph_lo, ph_hi;
};

typedef __bf16 bf16x2_t __attribute__((ext_vector_type(2)));
__device__ __forceinline__ unsigned pk2(float lo, float hi) { const f32x2 v = {lo, hi}; const bf16x2_t b = __builtin_convertvector(v, bf16x2_t); return __builtin_bit_cast(unsigned, b); }
__device__ __forceinline__ float frcp(float x) { return __builtin_amdgcn_rcpf(x); }
__device__ __forceinline__ float fsigmoid(float x) { return frcp(1.0f + __expf(-x)); }
__device__ __forceinline__ float fsilu(float x) { return x * fsigmoid(x); }
__device__ __forceinline__ float ftanh(float x) { return 1.0f - 2.0f * frcp(1.0f + __expf(2.0f * x)); }
__device__ __forceinline__ float fgelu(float x) { return 0.5f * x * (1.0f + ftanh(0.7978845608f * (x + 0.044715f * x * x * x))); }
__device__ __forceinline__ float bf2f(unsigned short b) { return __uint_as_float(((unsigned)b) << 16); }
__device__ __forceinline__ float wave_sum(float v) {
#pragma unroll
    for (int o = 1; o < 64; o <<= 1) v += __shfl_xor(v, o);
    return v;
}
__device__ __forceinline__ float sum16(float v) {
#pragma unroll
    for (int o = 1; o < 16; o <<= 1) v += __shfl_xor(v, o);
    return v;
}
__device__ __forceinline__ bf16x8 ld8f_bf16(const float* p) {
    const f32x4 a = *(const f32x4*)p, b = *(const f32x4*)(p + 4);
    u32x4 w; w.x = pk2(a.x, a.y); w.y = pk2(a.z, a.w); w.z = pk2(b.x, b.y); w.w = pk2(b.z, b.w);
    return __builtin_bit_cast(bf16x8, w);
}
__device__ __forceinline__ f32x4 ld4bf(const bf16_t* p) {
    const u32x2 w = *(const u32x2*)p; f32x4 r; r.x = __uint_as_float(w.x << 16); r.y = __uint_as_float(w.x & 0xffff0000u); r.z = __uint_as_float(w.y << 16); r.w = __uint_as_float(w.y & 0xffff0000u); return r;
}
__device__ __forceinline__ int cond_of_row(int row) { return row < MC ? 0 : 1 + ((row - MC) >> 10); }
#define MFMA16(a, b, c) __builtin_amdgcn_mfma_f32_16x16x32_bf16((a), (b), (c), 0, 0, 0)

typedef const __attribute__((address_space(4))) Params* CParams;
__device__ __forceinline__ CParams get_params() { CParams q = (CParams)__builtin_amdgcn_kernarg_segment_ptr(); asm volatile("" : "+s"(q)); return q; }

struct Frame {
    LAS unsigned char* lds; int tid, lane, wave, G, bid;
};
__device__ __forceinline__ Frame fresh(const Frame& F) { Frame R = F; asm volatile("" : "+v"(R.tid)); R.lane = R.tid & 63; return R; }

struct P0Item { const float* W; bf16_t* WT; int ldw, k0, n0, ldk, drow0, mode; };
__device__ __forceinline__ void p0_item_load(const P0Item& I, float (&v)[32], int lane) {
#pragma unroll
    for (int i = 0; i < 32; ++i) v[i] = I.W[(size_t)(I.k0 + 2 * i + (lane >> 5)) * I.ldw + I.n0 + (lane & 31)];
}
__device__ __forceinline__ void p0_item_park(const float (&v)[32], LAS float* scr, int lane) {
#pragma unroll
    for (int i = 0; i < 32; ++i) scr[(2 * i + (lane >> 5)) * 33 + (lane & 31)] = v[i];
}
__device__ __forceinline__ void p0_item_store(const P0Item& I, const LAS float* scr, int lane) {
    const int c = lane & 7;
#pragma unroll
    for (int j = 0; j < 4; ++j) { const int n = (lane >> 3) + 8 * j; const LAS float* s = scr + (8 * c) * 33 + n;
        u32x4 o; o.x = pk2(s[0 * 33], s[1 * 33]); o.y = pk2(s[2 * 33], s[3 * 33]); o.z = pk2(s[4 * 33], s[5 * 33]); o.w = pk2(s[6 * 33], s[7 * 33]);
        size_t off = (size_t)(I.drow0 + n) * I.ldk + I.k0 + 8 * c;
        if (I.mode) { const int rho = I.mode == 2 ? 16 * ((n >> 2) & 1) + 4 * (n >> 3) + (n & 3) : n;
            const int ob = (rho & 15) * 64 + (c & 3) * 16;
            off = ((size_t)((I.drow0 >> 4) + (rho >> 4)) * (I.ldk >> 5) + (I.k0 >> 5) + (c >> 2)) * 512 + ((ob ^ (((ob >> 9) & 1) << 5)) >> 1); }
        *(u32x4*)(I.WT + off) = o; }
}
__device__ __forceinline__ void p0_transpose_item(const float* W, int ldw, int k0, int n0, bf16_t* WT, int ldk, int drow0, LAS float* scr, int lane) {
#pragma unroll 8
    for (int i = 0; i < 32; ++i) { const int kk = 2 * i + (lane >> 5); scr[kk * 33 + (lane & 31)] = W[(size_t)(k0 + kk) * ldw + n0 + (lane & 31)]; }
    asm volatile("s_waitcnt lgkmcnt(0)" ::: "memory");
    const int c = lane & 7;
#pragma unroll
    for (int j = 0; j < 4; ++j) { const int n = (lane >> 3) + 8 * j; const LAS float* s = scr + (8 * c) * 33 + n;
        u32x4 o; o.x = pk2(s[0 * 33], s[1 * 33]); o.y = pk2(s[2 * 33], s[3 * 33]); o.z = pk2(s[4 * 33], s[5 * 33]); o.w = pk2(s[6 * 33], s[7 * 33]);
        *(u32x4*)(WT + (size_t)(drow0 + n) * ldk + k0 + 8 * c) = o; }
    asm volatile("s_waitcnt lgkmcnt(0)" ::: "memory");
}

constexpr int P0_I_FFI = 32 * 352, P0_I_FFO = 88 * 64, P0_I_IN = 32 * 157, P0_I_OUT = 32 * 64, P0_I_LR = 32;
constexpr int P0_NL = 2 * P0_I_FFI + 2 * P0_I_FFO + P0_I_IN + P0_I_OUT + 4 * P0_I_LR;
__device__ __forceinline__ P0Item p0_layer_desc(CParams p, int l, int it) {
    unsigned char* ws = p->ws; P0Item I; int r = it;
    if (r < 2 * P0_I_FFI) { const int mi = l * 2 + r / P0_I_FFI; r %= P0_I_FFI; const int kb = r / 352, nb = r % 352, n0 = nb * 32;
        const int j = n0 < DFF ? n0 : n0 - DFF; const int drow = 256 * (j >> 7) + (n0 < DFF ? 0 : 128) + (j & 127);
        I.W = p->ffn_w_in + (size_t)mi * D * NFF; I.ldw = NFF; I.k0 = kb * 64; I.n0 = n0; I.WT = (bf16_t*)(ws + WS_WFFI) + (size_t)mi * NFF * D; I.ldk = D; I.drow0 = drow; I.mode = 2; return I; }
    r -= 2 * P0_I_FFI;
    if (r < 2 * P0_I_FFO) { const int mi = l * 2 + r / P0_I_FFO; r %= P0_I_FFO; const int kb = r / 64, nb = r % 64;
        I.W = p->ffn_w_out + (size_t)mi * DFF * D; I.ldw = D; I.k0 = kb * 64; I.n0 = nb * 32; I.WT = (bf16_t*)(ws + WS_WFFO) + (size_t)mi * D * DFF; I.ldk = DFF; I.drow0 = nb * 32; I.mode = 2; return I; }
    r -= 2 * P0_I_FFO;
    if (r < P0_I_IN) { const int kb = r / 157, nb = r % 157;
        I.W = p->w_in + (size_t)l * D * NIN; I.ldw = NIN; I.k0 = kb * 64; I.n0 = nb * 32; I.WT = (bf16_t*)(ws + WS_WIN) + (size_t)l * NINP * D; I.ldk = D; I.drow0 = nb * 32; I.mode = 2; return I; }
    r -= P0_I_IN;
    if (r < P0_I_OUT) { const int kb = r / 64, nb = r % 64;
        I.W = p->w_out + (size_t)l * D * D; I.ldw = D; I.k0 = kb * 64; I.n0 = nb * 32; I.WT = (bf16_t*)(ws + WS_WOUT) + (size_t)l * D * D; I.ldk = D; I.drow0 = nb * 32; I.mode = 2; return I; }
    r -= P0_I_OUT;
    { const int q = r / P0_I_LR, nb = r % P0_I_LR, md = l * 2 + (q & 1);
      I.W = (q < 2 ? p->decay_w2 : p->iclr_a2) + (size_t)md * 64 * CW; I.ldw = CW; I.k0 = 0; I.n0 = nb * 32;
      I.WT = (bf16_t*)(ws + (q < 2 ? WS_W2T : WS_A2T)) + (size_t)md * CW * 64; I.ldk = 64; I.drow0 = nb * 32; I.mode = 0; return I; }
}
__device__ __forceinline__ void p0_layer_item(CParams p, int l, int it, LAS float* scr, int lane) {
    unsigned char* ws = p->ws;
    int r = it;
    if (r < 2 * P0_I_FFI) { const int mi = l * 2 + r / P0_I_FFI; r %= P0_I_FFI; const int kb = r / 352, nb = r % 352, n0 = nb * 32;
        const int j = n0 < DFF ? n0 : n0 - DFF; const int drow = 256 * (j >> 7) + (n0 < DFF ? 0 : 128) + (j & 127);
        p0_transpose_item(p->ffn_w_in + (size_t)mi * D * NFF, NFF, kb * 64, n0, (bf16_t*)(ws + WS_WFFI) + (size_t)mi * NFF * D, D, drow, scr, lane); return; }
    r -= 2 * P0_I_FFI;
    if (r < 2 * P0_I_FFO) { const int mi = l * 2 + r / P0_I_FFO; r %= P0_I_FFO; const int kb = r / 64, nb = r % 64;
        p0_transpose_item(p->ffn_w_out + (size_t)mi * DFF * D, D, kb * 64, nb * 32, (bf16_t*)(ws + WS_WFFO) + (size_t)mi * D * DFF, DFF, nb * 32, scr, lane); return; }
    r -= 2 * P0_I_FFO;
    if (r < P0_I_IN) { const int kb = r / 157, nb = r % 157;
        p0_transpose_item(p->w_in + (size_t)l * D * NIN, NIN, kb * 64, nb * 32, (bf16_t*)(ws + WS_WIN) + (size_t)l * NINP * D, D, nb * 32, scr, lane); return; }
    r -= P0_I_IN;
    if (r < P0_I_OUT) { const int kb = r / 64, nb = r % 64;
        p0_transpose_item(p->w_out + (size_t)l * D * D, D, kb * 64, nb * 32, (bf16_t*)(ws + WS_WOUT) + (size_t)l * D * D, D, nb * 32, scr, lane); return; }
    r -= P0_I_OUT;
    { const int q = r / P0_I_LR, nb = r % P0_I_LR, md = l * 2 + (q & 1);
      const float* W = (q < 2 ? p->decay_w2 : p->iclr_a2) + (size_t)md * 64 * CW;
      bf16_t* WT = (bf16_t*)(ws + (q < 2 ? WS_W2T : WS_A2T)) + (size_t)md * CW * 64;
      p0_transpose_item(W, CW, 0, nb * 32, WT, 64, nb * 32, scr, lane); }
}

__device__ __forceinline__ void p0_prologue(const Frame& F, CParams p) {
    unsigned char* ws = p->ws;
    LAS float* sl = (LAS float*)F.lds;
    LAS float* red = (LAS float*)(F.lds + 40960);
    for (int i = F.tid; i < 5 * 2048; i += NTHR) { const int c = i >> 11, k = i & 2047; const float v = (c == 0) ? p->c_ctx[k] : p->c[(c - 1) * 2048 + k]; sl[i] = fsilu(v); }
    __syncthreads();
    float* modp = (float*)(ws + WS_MODP);
    for (int u = F.bid; u < 2 * 72 * 4; u += F.G) {
        const int l = u / 288, r = u % 288, cb = r >> 2, kq = r & 3;
        const int kbase = kq * 512 + F.wave * 64, col = cb * 256 + F.lane * 4;
        const float* wp = p->w_mod + ((size_t)l * 2048 + kbase) * NMOD + col;
        f32x4 acc[5];
#pragma unroll
        for (int c = 0; c < 5; ++c) acc[c] = (f32x4){0.f, 0.f, 0.f, 0.f};
#pragma unroll 8
        for (int k = 0; k < 64; ++k) {
            const f32x4 w = *(const f32x4*)(wp + (size_t)k * NMOD);
#pragma unroll
            for (int c = 0; c < 5; ++c) acc[c] += w * sl[c * 2048 + kbase + k];
        }
#pragma unroll
        for (int c = 0; c < 5; ++c) *(LAS f32x4*)(red + (F.wave * 5 + c) * 256 + F.lane * 4) = acc[c];
        __syncthreads();
        if (F.tid < 320) { const int c = F.tid >> 6, q = F.tid & 63; f32x4 s = (f32x4){0.f, 0.f, 0.f, 0.f};
#pragma unroll
            for (int w = 0; w < 8; ++w) s += *(LAS f32x4*)(red + (w * 5 + c) * 256 + q * 4);
            *(f32x4*)(modp + ((size_t)(l * 4 + kq) * 5 + c) * NMOD + cb * 256 + q * 4) = s; }
        __syncthreads();
    }
    LAS float* scrA = (LAS float*)(F.lds + F.wave * 16896); LAS float* scrB = scrA + 2112;
    const int gw = F.bid * NWAVES + F.wave, NGW = F.G * NWAVES;
    for (int it = gw; it < 2 * P0_NL; it += 2 * NGW) {
        const int itb = it + NGW; const bool hasb = itb < 2 * P0_NL;
        const P0Item IA = p0_layer_desc(p, it >= P0_NL ? 1 : 0, it >= P0_NL ? it - P0_NL : it);
        const int itc = hasb ? itb : it;
        const P0Item IB = p0_layer_desc(p, itc >= P0_NL ? 1 : 0, itc >= P0_NL ? itc - P0_NL : itc);
        float va[32], vb[32];
        p0_item_load(IA, va, F.lane); p0_item_load(IB, vb, F.lane);
        p0_item_park(va, scrA, F.lane); p0_item_park(vb, scrB, F.lane);
        asm volatile("s_waitcnt lgkmcnt(0)" ::: "memory");
        p0_item_store(IA, scrA, F.lane);
        if (hasb) p0_item_store(IB, scrB, F.lane);
        asm volatile("s_waitcnt lgkmcnt(0)" ::: "memory");
    }
    const int gt = F.bid * NTHR + F.tid, NGT = F.G * NTHR;
    { bf16_t* g2t = (bf16_t*)(ws + WS_G2T);
      for (int i = gt; i < 2 * 1024 * 160; i += NGT) { const int l = i / (1024 * 160), r = i % (1024 * 160), n = r / 160, k = r % 160;
          g2t[i] = (bf16_t)(pk2(p->gate_w2[((size_t)l * 160 + k) * 1024 + n], 0.f) & 0xffffu); } }
    { bf16_t* sw = (bf16_t*)(ws + WS_SGUW);
      for (int i = gt; i < 2 * 4 * 128 * 128; i += NGT) sw[i] = (bf16_t)(pk2(p->sgu_w[i], 0.f) & 0xffffu); }
    { bf16_t* cs = (bf16_t*)(ws + WS_CS128);
      for (int i = gt; i < 256 * 128; i += NGT) { const int m = i >> 7, d = i & 127, ph = ((m & 127) * d) & 127; const float a = (float)ph * (1.0f / 64.0f);
          cs[i] = (bf16_t)(pk2(m < 128 ? cospif(a) : sinpif(a), 0.f) & 0xffffu); } }
    { bf16_t* dl = (bf16_t*)(ws + WS_DFTL); const float sc = 0.00276213586f;
      for (int i = gt; i < 1024 * 2048; i += NGT) { const int t = i >> 11, k = i & 2047, s = k & 1023, ph = (t * s) & 1023; const float a = (float)ph * (1.0f / 512.0f);
          dl[frag_addr(t, k, 2048)] = (bf16_t)(pk2((k < 1024 ? cospif(a) : -sinpif(a)) * sc, 0.f) & 0xffffu); } }
    { bf16_t* dc = (bf16_t*)(ws + WS_DFTC); const float sc = 0.00552427173f;
      for (int i = gt; i < 256 * 512; i += NGT) { const int t = i >> 9, k = i & 511, s = k & 255, ph = (t * s) & 255; const float a = (float)ph * (1.0f / 128.0f);
          dc[frag_addr(t, k, 512)] = (bf16_t)(pk2((k < 256 ? cospif(a) : -sinpif(a)) * sc, 0.f) & 0xffffu); } }
    { unsigned* wp = (unsigned*)(ws + WS_WIN);
      for (int i = gt; i < 2 * 96 * 1024; i += NGT) { const int l = i / (96 * 1024), r = i % (96 * 1024); wp[(size_t)l * NINP * 1024 + (size_t)NIN * 1024 + r] = 0u; } }
}

template <bool XF32> __device__ __forceinline__ void norm_phase(const Frame& F, CParams p, int l, int isub, const void* xc, const void* xl) {
    LAS float* gs = (LAS float*)F.lds;
    LAS float* sh = gs + 2048;
    const float* modp = (const float*)(p->ws + WS_MODP) + (size_t)l * 4 * 5 * NMOD;
    const float* bm = p->b_mod + (size_t)l * NMOD;
    const float* ng = p->norm_g + ((size_t)l * 3 + isub) * D;
    bf16_t* H = (bf16_t*)(p->ws + WS_H);
    if (isub == 0) {
        float* modf = (float*)(p->ws + WS_MODF) + (size_t)l * 5 * NMOD;
        for (int i = F.bid * NTHR + F.tid; i < 5 * NMOD / 4; i += F.G * NTHR) { const int c = i / (NMOD / 4), j4 = i % (NMOD / 4);
            f32x4 s = *(const f32x4*)(bm + 4 * j4);
#pragma unroll
            for (int q = 0; q < 4; ++q) s += *(const f32x4*)(modp + (size_t)(q * 5 + c) * NMOD + 4 * j4);
            *(f32x4*)(modf + (size_t)c * NMOD + 4 * j4) = s; }
    }
    const int hl = F.lane & 31, hrow = F.lane >> 5;
    for (int u = F.bid; u < M / 48; u += F.G) {
        int cur = -1;
        for (int rr = 0; rr < 3; ++rr) {
            const int row = u * 48 + rr * 16 + 2 * F.wave + hrow;
            const int c0 = cond_of_row(u * 48 + rr * 16);
            if (c0 != cur) {
                __syncthreads();
                for (int i = F.tid; i < 2048; i += NTHR) {
                    float s0 = bm[(3 * isub) * 2048 + i], s1 = bm[(3 * isub + 1) * 2048 + i];
#pragma unroll
                    for (int q = 0; q < 4; ++q) { s0 += modp[(size_t)(q * 5 + c0) * NMOD + (3 * isub) * 2048 + i]; s1 += modp[(size_t)(q * 5 + c0) * NMOD + (3 * isub + 1) * 2048 + i]; }
                    gs[i] = ng[i] * (1.0f + s1); sh[i] = s0;
                }
                __syncthreads();
                cur = c0;
            }
            const size_t xo = (row < MC ? (size_t)row : (size_t)(row - MC)) * D; const void* xb = row < MC ? xc : xl;
            f32x4 v[8][2]; float ss = 0.f;
#pragma unroll
            for (int j = 0; j < 8; ++j) { const int cidx = 8 * hl + 256 * j;
                if constexpr (XF32) { v[j][0] = *(const f32x4*)((const float*)xb + xo + cidx); v[j][1] = *(const f32x4*)((const float*)xb + xo + cidx + 4); }
                else { const u32x4 w = *(const u32x4*)((const bf16_t*)xb + pg8::blk_off(row < MC ? row : row - MC, cidx, D));
                    v[j][0] = (f32x4){__uint_as_float(w.x << 16), __uint_as_float(w.x & 0xffff0000u), __uint_as_float(w.y << 16), __uint_as_float(w.y & 0xffff0000u)};
                    v[j][1] = (f32x4){__uint_as_float(w.z << 16), __uint_as_float(w.z & 0xffff0000u), __uint_as_float(w.w << 16), __uint_as_float(w.w & 0xffff0000u)}; }
#pragma unroll
                for (int e = 0; e < 2; ++e) ss += (v[j][e].x * v[j][e].x + v[j][e].y * v[j][e].y) + (v[j][e].z * v[j][e].z + v[j][e].w * v[j][e].w); }
#pragma unroll
            for (int o = 1; o < 32; o <<= 1) ss += __shfl_xor(ss, o);
            const float rstd = __builtin_amdgcn_rsqf(ss * (1.0f / D) + 1e-6f);
#pragma unroll
            for (int j = 0; j < 8; ++j) { const int cidx = 8 * hl + 256 * j;
                const f32x4 g0 = *(LAS f32x4*)(gs + cidx), g1 = *(LAS f32x4*)(gs + cidx + 4), s0 = *(LAS f32x4*)(sh + cidx), s1 = *(LAS f32x4*)(sh + cidx + 4);
                const f32x4 o0 = v[j][0] * rstd * g0 + s0, o1 = v[j][1] * rstd * g1 + s1;
                u32x4 w; w.x = pk2(o0.x, o0.y); w.y = pk2(o0.z, o0.w); w.z = pk2(o1.x, o1.y); w.w = pk2(o1.z, o1.w);
                *(u32x4*)(H + pg8::blk_off(row, cidx, D)) = w; }
        }
        __syncthreads();
    }
}
__device__ __forceinline__ void final_phase(const Frame& F, CParams p) {
    const bf16_t* X = (const bf16_t*)(p->ws + WS_X);
    const int gw = F.bid * NWAVES + F.wave, NGW = F.G * NWAVES;
    for (int row = gw; row < M; row += NGW) {
        const bf16_t* xr = X + (size_t)row * D; float* orow = p->out + (size_t)row * D;
        f32x4 v[8]; float ss = 0.f;
#pragma unroll
        for (int j = 0; j < 8; ++j) { v[j] = ld4bf(X + pg8::blk_off(row, 4 * F.lane + 256 * j, D)); ss += (v[j].x * v[j].x + v[j].y * v[j].y) + (v[j].z * v[j].z + v[j].w * v[j].w); }
        const float rstd = __builtin_amdgcn_rsqf(wave_sum(ss) * (1.0f / D) + 1e-6f);
#pragma unroll
        for (int j = 0; j < 8; ++j) { const int cidx = 4 * F.lane + 256 * j; const f32x4 g4 = *(const f32x4*)(p->final_g + cidx); *(f32x4*)(orow + cidx) = v[j] * rstd * g4; }
    }
}

__device__ __forceinline__ void sgu_prep8(const Frame& F, CParams p, int l, int row0) {
    const bf16_t* Z = (const bf16_t*)(p->ws + WS_Z);
    bf16_t* U = (bf16_t*)(p->ws + WS_U); bf16_t* VNT = (bf16_t*)(p->ws + WS_VNT);
    f32x4 gv[8][2]; float mean[8], rstd[8];
#define UNP8(w_, lo_, hi_) do { lo_ = (f32x4){__uint_as_float(w_.x << 16), __uint_as_float(w_.x & 0xffff0000u), __uint_as_float(w_.y << 16), __uint_as_float(w_.y & 0xffff0000u)}; \
                                 hi_ = (f32x4){__uint_as_float(w_.z << 16), __uint_as_float(w_.z & 0xffff0000u), __uint_as_float(w_.w << 16), __uint_as_float(w_.w & 0xffff0000u)}; } while (0)
#pragma unroll
    for (int j = 0; j < 8; ++j) {
        const bf16_t* zr = Z + (size_t)(row0 + j) * NINP;
        const u32x4 wu = *(const u32x4*)(zr + 8 * F.lane), wv = *(const u32x4*)(zr + 512 + 8 * F.lane);
        f32x4 a0, a1, b0, b1; UNP8(wu, a0, a1); UNP8(wv, b0, b1);
        u32x4 w; w.x = pk2(fgelu(a0.x), fgelu(a0.y)); w.y = pk2(fgelu(a0.z), fgelu(a0.w)); w.z = pk2(fgelu(a1.x), fgelu(a1.y)); w.w = pk2(fgelu(a1.z), fgelu(a1.w));
        *(u32x4*)(U + (size_t)(row0 + j) * 512 + 8 * F.lane) = w;
        f32x4 g0, g1; g0.x = fgelu(b0.x); g0.y = fgelu(b0.y); g0.z = fgelu(b0.z); g0.w = fgelu(b0.w); g1.x = fgelu(b1.x); g1.y = fgelu(b1.y); g1.z = fgelu(b1.z); g1.w = fgelu(b1.w);
        gv[j][0] = g0; gv[j][1] = g1;
        const float s = ((g0.x + g0.y) + (g0.z + g0.w)) + ((g1.x + g1.y) + (g1.z + g1.w));
        const float mu = wave_sum(s) * (1.0f / 512.0f); float q = 0.f;
#pragma unroll
        for (int i = 0; i < 2; ++i) { const f32x4 d = gv[j][i] - mu; q += (d.x * d.x + d.y * d.y) + (d.z * d.z + d.w * d.w); }
        mean[j] = mu; rstd[j] = __builtin_amdgcn_rsqf(wave_sum(q) * (1.0f / 512.0f) + 1e-5f);
    }
#undef UNP8
    const int chunk = row0 >> 7, s0 = row0 & 127;
    const float* lg = p->sgu_ln_g + l * 512; const float* lb = p->sgu_ln_b + l * 512;
#pragma unroll
    for (int i = 0; i < 2; ++i) {
        const int ch0 = 8 * F.lane + 4 * i;
        const f32x4 g4 = *(const f32x4*)(lg + ch0), b4 = *(const f32x4*)(lb + ch0);
#pragma unroll
        for (int e = 0; e < 4; ++e) {
            float o[8];
#pragma unroll
            for (int j = 0; j < 8; ++j) o[j] = (gv[j][i][e] - mean[j]) * rstd[j] * g4[e] + b4[e];
            u32x4 w; w.x = pk2(o[0], o[1]); w.y = pk2(o[2], o[3]); w.z = pk2(o[4], o[5]); w.w = pk2(o[6], o[7]);
            *(u32x4*)(VNT + ((size_t)chunk * 512 + ch0 + e) * 128 + s0) = w;
        }
    }
}
__device__ __forceinline__ void rwkv_elem_row(const Frame& F, CParams p, int l, int row) {
    unsigned char* ws = p->ws;
    const bf16_t* Z = (const bf16_t*)(ws + WS_Z);
    float* R = (float*)(ws + WS_SC); float* Kb = R + (size_t)M * CW; float* V = Kb + (size_t)M * CW;
    float* INVN = (float*)(ws + WS_INVN);
    bf16_t* TW = (bf16_t*)(ws + WS_TW); bf16_t* AD = (bf16_t*)(ws + WS_AD); bf16_t* GS = (bf16_t*)(ws + WS_GS);
    const float* mu = p->shift_mu + (size_t)l * CIN; const float* kkp = p->k_k + l * CW;
    int s0, s1, s2, s3, lim1, lim2, lim3;
    if (row < MC) { const int pos = row & 255; s0 = pos > 0 ? row - 1 : -1; s1 = pos < 255 ? row + 1 : -1; s2 = s1; s3 = s1; lim1 = 218; lim2 = 218; lim3 = 218; }
    else { const int pos = (row - MC) & 1023, gc = pos & 63, gr = pos >> 6;
        s0 = gc > 0 ? row - 1 : -1; s1 = gc < 63 ? row + 1 : -1; s2 = gr > 0 ? row - 64 : -1; s3 = gr < 15 ? row + 64 : -1; lim1 = 109; lim2 = 218; lim3 = 327; }
    const bf16_t* zr = Z + (size_t)row * NINP + ZC0;
    u32x4 zcv[7], zsv[7];
#pragma unroll
    for (int it = 0; it < 7; ++it) {
        const int i8 = it * 64 + F.lane; const bool on = (it < 6) || (F.lane < 52);
        const int src = i8 < lim1 ? s0 : (i8 < lim2 ? s1 : (i8 < lim3 ? s2 : s3));
        zcv[it] = (u32x4){0u, 0u, 0u, 0u}; zsv[it] = (u32x4){0u, 0u, 0u, 0u};
        if (on) { zcv[it] = *(const u32x4*)(zr + 8 * i8); if (src >= 0) zsv[it] = *(const u32x4*)(Z + (size_t)src * NINP + ZC0 + 8 * i8); }
    }
    asm volatile("" ::: "memory");
#define ZMIX8(it_, i8_, lo_, hi_) do { const int i8q = (i8_); const u32x4 zc_ = zcv[it_], zs_ = zsv[it_]; \
        const f32x4 m0_ = *(const f32x4*)(mu + 8 * i8q), m1_ = *(const f32x4*)(mu + 8 * i8q + 4); \
        const f32x4 c0_ = (f32x4){__uint_as_float(zc_.x << 16), __uint_as_float(zc_.x & 0xffff0000u), __uint_as_float(zc_.y << 16), __uint_as_float(zc_.y & 0xffff0000u)}; \
        const f32x4 c1_ = (f32x4){__uint_as_float(zc_.z << 16), __uint_as_float(zc_.z & 0xffff0000u), __uint_as_float(zc_.w << 16), __uint_as_float(zc_.w & 0xffff0000u)}; \
        const f32x4 n0_ = (f32x4){__uint_as_float(zs_.x << 16), __uint_as_float(zs_.x & 0xffff0000u), __uint_as_float(zs_.y << 16), __uint_as_float(zs_.y & 0xffff0000u)}; \
        const f32x4 n1_ = (f32x4){__uint_as_float(zs_.z << 16), __uint_as_float(zs_.z & 0xffff0000u), __uint_as_float(zs_.w << 16), __uint_as_float(zs_.w & 0xffff0000u)}; \
        lo_ = c0_ + (n0_ - c0_) * m0_; hi_ = c1_ + (n1_ - c1_) * m1_; } while (0)
#pragma unroll
    for (int it = 0; it < 2; ++it) { const int i8 = it * 64 + F.lane; f32x4 a, b; ZMIX8(it, i8, a, b); float* o = R + (size_t)row * CW + 8 * i8; *(f32x4*)o = a; *(f32x4*)(o + 4) = b; }
#pragma unroll
    for (int it = 0; it < 2; ++it) {
        const int i8 = 128 + it * 64 + F.lane, c = 8 * (i8 - 128); f32x4 a, b; ZMIX8(2 + it, i8, a, b);
        float* o = Kb + (size_t)row * CW + c; *(f32x4*)o = a; *(f32x4*)(o + 4) = b;
        const f32x4 ka = a * *(const f32x4*)(kkp + c), kb = b * *(const f32x4*)(kkp + c + 4);
        float ss = ((ka.x * ka.x + ka.y * ka.y) + (ka.z * ka.z + ka.w * ka.w)) + ((kb.x * kb.x + kb.y * kb.y) + (kb.z * kb.z + kb.w * kb.w));
        ss += __shfl_xor(ss, 1); ss += __shfl_xor(ss, 2); ss += __shfl_xor(ss, 4);
        const float invn = frcp(fmaxf(sqrtf(ss), 1e-12f));
        if ((F.lane & 7) == 0) INVN[(size_t)row * 16 + it * 8 + (F.lane >> 3)] = invn;
    }
#pragma unroll
    for (int it = 0; it < 2; ++it) { const int i8 = 256 + it * 64 + F.lane; f32x4 a, b; ZMIX8(4 + it, i8, a, b); float* o = V + (size_t)row * CW + 8 * (i8 - 256); *(f32x4*)o = a; *(f32x4*)(o + 4) = b; }
    if (F.lane < 52) {
        const int i8 = 384 + F.lane; f32x4 a, b; ZMIX8(6, i8, a, b); u32x4 w;
        if (F.lane < 16) { w.x = pk2(ftanh(a.x), ftanh(a.y)); w.y = pk2(ftanh(a.z), ftanh(a.w)); w.z = pk2(ftanh(b.x), ftanh(b.y)); w.w = pk2(ftanh(b.z), ftanh(b.w)); *(u32x4*)(TW + (size_t)row * 128 + 8 * F.lane) = w; }
        else if (F.lane < 32) { w.x = pk2(a.x, a.y); w.y = pk2(a.z, a.w); w.z = pk2(b.x, b.y); w.w = pk2(b.z, b.w); *(u32x4*)(AD + (size_t)row * 128 + 8 * (F.lane - 16)) = w; }
        else { w.x = pk2(fsigmoid(a.x), fsigmoid(a.y)); w.y = pk2(fsigmoid(a.z), fsigmoid(a.w)); w.z = pk2(fsigmoid(b.x), fsigmoid(b.y)); w.w = pk2(fsigmoid(b.z), fsigmoid(b.w)); *(u32x4*)(GS + (size_t)row * 160 + 8 * (F.lane - 32)) = w; }
    }
#undef ZMIX8
}
template <int CTRL> __device__ __forceinline__ float dppf0(float x) { return __builtin_bit_cast(float, __builtin_amdgcn_update_dpp(0, __builtin_bit_cast(int, x), CTRL, 0xf, 0xf, true)); }
template <int CTRL> __device__ __forceinline__ f32x4 dppv(f32x4 x) { f32x4 r; r.x = dppf0<CTRL>(x.x); r.y = dppf0<CTRL>(x.y); r.z = dppf0<CTRL>(x.z); r.w = dppf0<CTRL>(x.w); return r; }
template <int MT> __device__ __forceinline__ void lowrank_tile(const Frame& F, CParams p, int l, int tok0, const LAS float* biasL) {
    unsigned char* ws = p->ws;
    const int fr = F.lane & 15, fq = F.lane >> 4;
    bf16x8 wf[2][4], af[2][MT];
#define LR_LOAD(g_, w_, a_) do { const int td_ = (g_) >> 1, nh_ = (g_) & 1, ty_ = td_ >> 1, dr_ = td_ & 1; \
        const bf16_t* Wt_ = (const bf16_t*)(ws + (ty_ == 0 ? WS_W2T : WS_A2T)) + (size_t)(l * 2 + dr_) * CW * 64 + (size_t)(128 * F.wave + 64 * nh_ + fr) * 64 + 8 * fq; \
        const bf16_t* Ac_ = (const bf16_t*)(ws + (ty_ == 0 ? WS_TW : WS_AD)) + (size_t)(tok0 + fr) * 128 + dr_ * 64 + 8 * fq; \
        _Pragma("unroll") for (int ks = 0; ks < 2; ++ks) { \
            _Pragma("unroll") for (int nt = 0; nt < 4; ++nt) w_[ks][nt] = *(const bf16x8*)(Wt_ + (size_t)(nt * 16) * 64 + ks * 32); \
            _Pragma("unroll") for (int mt = 0; mt < MT; ++mt) a_[ks][mt] = *(const bf16x8*)(Ac_ + (size_t)(mt * 16) * 128 + ks * 32); } } while (0)
    LR_LOAD(0, wf, af);
#define LR_USE() do { _Pragma("unroll") for (int ks = 0; ks < 2; ++ks) { _Pragma("unroll") for (int nt = 0; nt < 4; ++nt) asm volatile("" :: "v"(wf[ks][nt])); _Pragma("unroll") for (int mt = 0; mt < MT; ++mt) asm volatile("" :: "v"(af[ks][mt])); } } while (0)
    LR_USE();
#pragma unroll 1
    for (int g = 0; g < 8; ++g) {
        const int td = g >> 1, nh = g & 1, type = td >> 1, dir = td & 1;
        const LAS float* bias = biasL + td * CW;
        float* Out = (float*)(ws + WS_SC + (size_t)(3 + type * 2 + dir) * SC_ARR);
        {
            const int n0 = 128 * F.wave + 64 * nh;
            f32x4 acc[MT][4];
#pragma unroll
            for (int a = 0; a < MT; ++a)
#pragma unroll
                for (int b = 0; b < 4; ++b) acc[a][b] = (f32x4){0.f, 0.f, 0.f, 0.f};
#pragma unroll
            for (int ks = 0; ks < 2; ++ks)
#pragma unroll
                for (int mt = 0; mt < MT; ++mt)
#pragma unroll
                    for (int nt = 0; nt < 4; ++nt) acc[mt][nt] = MFMA16(wf[ks][nt], af[ks][mt], acc[mt][nt]);
            { const int gn = g < 7 ? g + 1 : 7; LR_LOAD(gn, wf, af); }
            __builtin_amdgcn_sched_barrier(0);
#pragma unroll
            for (int nt = 0; nt < 4; ++nt) {
                const int n = n0 + nt * 16 + 4 * fq;
                const f32x4 b4 = *(const LAS f32x4*)(bias + n);
#pragma unroll
                for (int mt = 0; mt < MT; ++mt) {
                    const f32x4 x = acc[mt][nt] + b4; f32x4 o;
                    if (type == 0) {
                        o.x = 0.875f * fsigmoid(x.x); o.y = 0.875f * fsigmoid(x.y); o.z = 0.875f * fsigmoid(x.z); o.w = 0.875f * fsigmoid(x.w);
                        o = o * 1.0000284f;
                        if (dir == 0) { o = o + dppv<0x111>(o); o = o + dppv<0x112>(o); o = o + dppv<0x114>(o); o = o + dppv<0x118>(o); }
                        else          { o = o + dppv<0x101>(o); o = o + dppv<0x102>(o); o = o + dppv<0x104>(o); o = o + dppv<0x108>(o); }
                    }
                    else { o.x = fsigmoid(x.x); o.y = fsigmoid(x.y); o.z = fsigmoid(x.z); o.w = fsigmoid(x.w); }
                    *(f32x4*)(Out + (size_t)(tok0 + mt * 16 + fr) * CW + n) = o;
                }
            }
        }
        LR_USE();
    }
#undef LR_USE
#undef LR_LOAD
    {
        const bf16_t* Wt = (const bf16_t*)(ws + WS_G2T) + (size_t)l * CW * 160;
        const bf16_t* Act = (const bf16_t*)(ws + WS_GS);
        bf16_t* G = (bf16_t*)(ws + WS_G);
#pragma unroll
        for (int nh = 0; nh < 2; ++nh) {
            const int n0 = 128 * F.wave + 64 * nh;
            f32x4 acc[MT][4];
#pragma unroll
            for (int a = 0; a < MT; ++a)
#pragma unroll
                for (int b = 0; b < 4; ++b) acc[a][b] = (f32x4){0.f, 0.f, 0.f, 0.f};
#pragma unroll
            for (int ks = 0; ks < 5; ++ks) {
                bf16x8 wf[4], af[MT];
#pragma unroll
                for (int nt = 0; nt < 4; ++nt) wf[nt] = *(const bf16x8*)(Wt + (size_t)(n0 + nt * 16 + fr) * 160 + ks * 32 + 8 * fq);
#pragma unroll
                for (int mt = 0; mt < MT; ++mt) af[mt] = *(const bf16x8*)(Act + (size_t)(tok0 + mt * 16 + fr) * 160 + ks * 32 + 8 * fq);
#pragma unroll
                for (int mt = 0; mt < MT; ++mt)
#pragma unroll
                    for (int nt = 0; nt < 4; ++nt) acc[mt][nt] = MFMA16(wf[nt], af[mt], acc[mt][nt]);
            }
#pragma unroll
            for (int nt = 0; nt < 4; ++nt)
#pragma unroll
                for (int mt = 0; mt < MT; ++mt) { const f32x4 x = acc[mt][nt]; u32x2 w; w.x = pk2(x.x, x.y); w.y = pk2(x.z, x.w);
                    *(u32x2*)(G + (size_t)(tok0 + mt * 16 + fr) * CW + n0 + nt * 16 + 4 * fq) = w; }
        }
    }
}
__device__ __forceinline__ void fnet_local_unit(const Frame& F, CParams p, int u) {
    unsigned char* ws = p->ws;
    const bf16_t* Z = (const bf16_t*)(ws + WS_Z);
    const bf16_t* CS = (const bf16_t*)(ws + WS_CS128);
    const int fr = F.lane & 15, fq = F.lane >> 4;
    int L, seqrow0, g, mt, st; bf16_t* tb;
    if (u < 2048) { const int b = u >> 6; g = (u >> 4) & 3; mt = (u >> 2) & 3; st = u & 3; L = 256; seqrow0 = b * 256; tb = (bf16_t*)(ws + WS_TTB) + (size_t)(b * 512) * 512; }
    else { const int v = u - 2048, b = v >> 8; g = (v >> 6) & 3; mt = (v >> 4) & 3; st = v & 15; L = 1024; seqrow0 = MC + b * 1024;
        tb = (bf16_t*)(ws + WS_TTB) + (size_t)32 * 4 * 128 * 512 + (size_t)(b * 512) * 2048; }
    f32x4 acc[4][4];
#pragma unroll
    for (int a = 0; a < 4; ++a)
#pragma unroll
        for (int b = 0; b < 4; ++b) acc[a][b] = (f32x4){0.f, 0.f, 0.f, 0.f};
#pragma unroll
    for (int ks = 0; ks < 4; ++ks) {
        bf16x8 cf[4], xf[4];
#pragma unroll
        for (int mi = 0; mi < 4; ++mi) cf[mi] = *(const bf16x8*)(CS + (size_t)(64 * mt + 16 * mi + fr) * 128 + 32 * ks + 8 * fq);
#pragma unroll
        for (int si = 0; si < 4; ++si) xf[si] = *(const bf16x8*)(Z + (size_t)(seqrow0 + 64 * st + 16 * si + fr) * NINP + 1024 + g * 128 + 32 * ks + 8 * fq);
#pragma unroll
        for (int mi = 0; mi < 4; ++mi)
#pragma unroll
            for (int si = 0; si < 4; ++si) acc[mi][si] = MFMA16(xf[si], cf[mi], acc[mi][si]);
    }
    const int cs = mt >> 1;
#pragma unroll
    for (int mi = 0; mi < 4; ++mi) {
        const int dp = (mt & 1) * 64 + 16 * mi + fr;
#pragma unroll
        for (int si = 0; si < 4; ++si) { const f32x4 x = acc[mi][si]; u32x2 w; w.x = pk2(x.x, x.y); w.y = pk2(x.z, x.w);
            *(u32x2*)(tb + frag_addr(g * 128 + dp, cs * L + 64 * st + 16 * si + 4 * fq, 2 * L)) = w; }
    }
}
__device__ __forceinline__ void mixprep_phase(const Frame& F, CParams p, int l) {
    LAS float* biasL = (LAS float*)F.lds;
    for (int i = F.tid; i < 4 * CW / 4; i += NTHR) { const int td = i >> 8, j4 = i & 255;
        *(LAS f32x4*)(biasL + td * CW + 4 * j4) = *(const f32x4*)(((td >> 1) == 0 ? p->decay_w0 : p->iclr_a0) + (size_t)(l * 2 + (td & 1)) * CW + 4 * j4); }
    __syncthreads();
    for (int dupa = 0; dupa < DBG_P6A; ++dupa)
    for (int u = F.bid; u < M / 48; u += F.G) {
        const int tok0 = u * 48, row0 = tok0 + 6 * F.wave;
        for (int dr = 0; dr < DBG_P6R; ++dr)
#pragma unroll 1
        for (int j = 0; j < 6; ++j) rwkv_elem_row(F, p, l, row0 + j);
        asm volatile("s_waitcnt vmcnt(0)" ::: "memory");
        __syncthreads();
        for (int dl = 0; dl < DBG_P6L; ++dl) lowrank_tile<3>(F, p, l, tok0, biasL);
    }
    const int NGW = F.G * NWAVES, gw = F.bid * NWAVES + F.wave;
    for (int dupb = 0; dupb < DBG_P6B; ++dupb)
    for (int u = gw; u < M / 8 + 3072; u += NGW) {
        if (u < M / 8) sgu_prep8(F, p, l, 8 * u); else fnet_local_unit(F, p, u - M / 8);
    }
}

#if defined(DBG_SAFE_DPP)
#define DPP_BC(J, x) __builtin_bit_cast(float, __builtin_amdgcn_update_dpp(0, __builtin_bit_cast(int, (x)), 0x150 + (J), 0xf, 0xf, true))
#define DPP_FMAC(J, acc, vec, s) acc = fmaf(DPP_BC(J, vec), (s), acc)
#define DPP_MUL(J, dst, vec, s) dst = DPP_BC(J, vec) * (s)
#else
#define DPP_FMAC(J, acc, vec, s) asm("v_fmac_f32_dpp %0, %1, %2 row_newbcast:" #J " row_mask:0xf bank_mask:0xf" : "+v"(acc) : "v"(vec), "v"(s))
#define DPP_MUL(J, dst, vec, s) asm("v_mul_f32_dpp %0, %1, %2 row_newbcast:" #J " row_mask:0xf bank_mask:0xf" : "=v"(dst) : "v"(vec), "v"(s))
#endif
__device__ __forceinline__ float segsum(float x) {
#if defined(DBG_SAFE_SEGSUM)
    x += __shfl_xor(x, 16); x += __shfl_xor(x, 32); return x;
#elif !defined(DBG_BUILTIN_SWAP)
    float t;
    asm volatile("v_mov_b32 %1, %0\n\ts_nop 1\n\tv_permlane32_swap_b32 %0, %1\n\ts_nop 1\n\tv_add_f32 %0, %0, %1\n\tv_mov_b32 %1, %0\n\ts_nop 1\n\tv_permlane16_swap_b32 %0, %1\n\ts_nop 1\n\tv_add_f32 %0, %0, %1"
                 : "+v"(x), "=&v"(t));
    return x;
#endif
    const unsigned xu = __float_as_uint(x);
    const auto r = __builtin_amdgcn_permlane32_swap(xu, xu, false, false);
    const float s = __uint_as_float(r[0]) + __uint_as_float(r[1]);
    const unsigned su = __float_as_uint(s);
    const auto q = __builtin_amdgcn_permlane16_swap(su, su, false, false);
    return __uint_as_float(q[0]) + __uint_as_float(q[1]);
}
struct ScanIn { float k, r, a, d, nv, v; };
__device__ __forceinline__ void scan_job(const Frame& F, CParams p, int l, int job) {
    unsigned char* ws = p->ws;
    const bool lat = job < 512; const int q = lat ? job : job - 512;
    const int chain = q >> 2, rb = q & 3, b = chain >> 5, h = (chain & 31) >> 1, dir = chain & 1;
    const int L = lat ? 1024 : 256, base = lat ? MC + b * 1024 : b * 256;
    const int seg = F.lane >> 4, li = F.lane & 15;
    const size_t srow = ((size_t)(((b * 2 + l) * 2 + dir) * 16 + h) * 64 + 16 * rb + li) * 64 + 16 * seg;
    float S[16];
    if (lat) {
        const float* s0 = p->state_wkv + srow;
#pragma unroll
        for (int j = 0; j < 4; ++j) { const f32x4 t = *(const f32x4*)(s0 + 4 * j); S[4 * j] = t.x; S[4 * j + 1] = t.y; S[4 * j + 2] = t.z; S[4 * j + 3] = t.w; }
    } else {
#pragma unroll
        for (int j = 0; j < 16; ++j) S[j] = 0.f;
    }
    const float* R = (const float*)(ws + WS_SC); const float* Kb = R + (size_t)M * CW; const float* V = Kb + (size_t)M * CW;
    const float* DEC = R + (size_t)(3 + dir) * M * CW; const float* A = R + (size_t)(5 + dir) * M * CW;
    const float* INVN = (const float*)(ws + WS_INVN);
    float* Y = (float*)(ws + WS_Z) + (size_t)dir * M * CW;
    const unsigned col = h * 64 + F.lane, vcol = h * 64 + 16 * rb + li;
    const float kkc = p->k_k[l * CW + col], kac = p->k_a[l * CW + col];
    const int rstep = dir ? -1 : 1, rfirst = dir ? base + L - 1 : base;
#define SCAN_LOAD(dst, t_) do { const int tq_ = (t_) < L ? (t_) : L - 1; const size_t ro_ = (size_t)(unsigned)__builtin_amdgcn_readfirstlane(rfirst + rstep * tq_); \
        const float* kr_ = Kb + ro_ * CW; const float* rr_ = R + ro_ * CW; const float* ar_ = A + ro_ * CW; const float* dr_ = DEC + ro_ * CW; const float* vr_ = V + ro_ * CW; \
        dst.k = kr_[col]; dst.r = rr_[col]; dst.a = ar_[col]; dst.d = dr_[col]; dst.nv = INVN[ro_ * 16 + h]; dst.v = vr_[vcol]; } while (0)
#if defined(DBG_STUB_SCAN)
    for (int t = 0; t < L; ++t) if (F.lane < 16) Y[(size_t)(rfirst + rstep * t) * CW + vcol] = 0.f;
    if (0) {
#else
    {
#endif
    if (lat) __builtin_amdgcn_s_setprio(LAT_PRIO);
#define SCAN_SA_ASM() asm("v_fmac_f32_dpp %[a0], %[kk], %[s0] row_newbcast:0 row_mask:0xf bank_mask:0xf\n\tv_fmac_f32_dpp %[a1], %[kk], %[s1] row_newbcast:1 row_mask:0xf bank_mask:0xf\n\tv_fmac_f32_dpp %[a0], %[kk], %[s2] row_newbcast:2 row_mask:0xf bank_mask:0xf\n\tv_fmac_f32_dpp %[a1], %[kk], %[s3] row_newbcast:3 row_mask:0xf bank_mask:0xf\n\tv_fmac_f32_dpp %[a0], %[kk], %[s4] row_newbcast:4 row_mask:0xf bank_mask:0xf\n\tv_fmac_f32_dpp %[a1], %[kk], %[s5] row_newbcast:5 row_mask:0xf bank_mask:0xf\n\tv_fmac_f32_dpp %[a0], %[kk], %[s6] row_newbcast:6 row_mask:0xf bank_mask:0xf\n\tv_fmac_f32_dpp %[a1], %[kk], %[s7] row_newbcast:7 row_mask:0xf bank_mask:0xf\n\tv_fmac_f32_dpp %[a0], %[kk], %[s8] row_newbcast:8 row_mask:0xf bank_mask:0xf\n\tv_fmac_f32_dpp %[a1], %[kk], %[s9] row_newbcast:9 row_mask:0xf bank_mask:0xf\n\tv_fmac_f32_dpp %[a0], %[kk], %[s10] row_newbcast:10 row_mask:0xf bank_mask:0xf\n\tv_fmac_f32_dpp %[a1], %[kk], %[s11] row_newbcast:11 row_mask:0xf bank_mask:0xf\n\tv_fmac_f32_dpp %[a0], %[kk], %[s12] row_newbcast:12 row_mask:0xf bank_mask:0xf\n\tv_fmac_f32_dpp %[a1], %[kk], %[s13] row_newbcast:13 row_mask:0xf bank_mask:0xf\n\tv_fmac_f32_dpp %[a0], %[kk], %[s14] row_newbcast:14 row_mask:0xf bank_mask:0xf\n\tv_fmac_f32_dpp %[a1], %[kk], %[s15] row_newbcast:15 row_mask:0xf bank_mask:0xf" : [a0] "+v"(sa0), [a1] "+v"(sa1) : [s0] "v"(S[0]), [s1] "v"(S[1]), [s2] "v"(S[2]), [s3] "v"(S[3]), [s4] "v"(S[4]), [s5] "v"(S[5]), [s6] "v"(S[6]), [s7] "v"(S[7]), [s8] "v"(S[8]), [s9] "v"(S[9]), [s10] "v"(S[10]), [s11] "v"(S[11]), [s12] "v"(S[12]), [s13] "v"(S[13]), [s14] "v"(S[14]), [s15] "v"(S[15]), [kk] "v"(kkv))
#define SCAN_UPD_ASM_LO() asm("v_mul_f32_dpp %[s0], %[d], %[s0] row_newbcast:0 row_mask:0xf bank_mask:0xf\n\tv_mul_f32_dpp %[s1], %[d], %[s1] row_newbcast:1 row_mask:0xf bank_mask:0xf\n\tv_mul_f32_dpp %[s2], %[d], %[s2] row_newbcast:2 row_mask:0xf bank_mask:0xf\n\tv_mul_f32_dpp %[s3], %[d], %[s3] row_newbcast:3 row_mask:0xf bank_mask:0xf\n\tv_mul_f32_dpp %[s4], %[d], %[s4] row_newbcast:4 row_mask:0xf bank_mask:0xf\n\tv_mul_f32_dpp %[s5], %[d], %[s5] row_newbcast:5 row_mask:0xf bank_mask:0xf\n\tv_mul_f32_dpp %[s6], %[d], %[s6] row_newbcast:6 row_mask:0xf bank_mask:0xf\n\tv_mul_f32_dpp %[s7], %[d], %[s7] row_newbcast:7 row_mask:0xf bank_mask:0xf\n\tv_fmac_f32_dpp %[s0], %[ka], %[nsa] row_newbcast:0 row_mask:0xf bank_mask:0xf\n\tv_fmac_f32_dpp %[s1], %[ka], %[nsa] row_newbcast:1 row_mask:0xf bank_mask:0xf\n\tv_fmac_f32_dpp %[s2], %[ka], %[nsa] row_newbcast:2 row_mask:0xf bank_mask:0xf\n\tv_fmac_f32_dpp %[s3], %[ka], %[nsa] row_newbcast:3 row_mask:0xf bank_mask:0xf\n\tv_fmac_f32_dpp %[s4], %[ka], %[nsa] row_newbcast:4 row_mask:0xf bank_mask:0xf\n\tv_fmac_f32_dpp %[s5], %[ka], %[nsa] row_newbcast:5 row_mask:0xf bank_mask:0xf\n\tv_fmac_f32_dpp %[s6], %[ka], %[nsa] row_newbcast:6 row_mask:0xf bank_mask:0xf\n\tv_fmac_f32_dpp %[s7], %[ka], %[nsa] row_newbcast:7 row_mask:0xf bank_mask:0xf\n\tv_fmac_f32_dpp %[s0], %[km], %[vv] row_newbcast:0 row_mask:0xf bank_mask:0xf\n\tv_fmac_f32_dpp %[s1], %[km], %[vv] row_newbcast:1 row_mask:0xf bank_mask:0xf\n\tv_fmac_f32_dpp %[s2], %[km], %[vv] row_newbcast:2 row_mask:0xf bank_mask:0xf\n\tv_fmac_f32_dpp %[s3], %[km], %[vv] row_newbcast:3 row_mask:0xf bank_mask:0xf\n\tv_fmac_f32_dpp %[s4], %[km], %[vv] row_newbcast:4 row_mask:0xf bank_mask:0xf\n\tv_fmac_f32_dpp %[s5], %[km], %[vv] row_newbcast:5 row_mask:0xf bank_mask:0xf\n\tv_fmac_f32_dpp %[s6], %[km], %[vv] row_newbcast:6 row_mask:0xf bank_mask:0xf\n\tv_fmac_f32_dpp %[s7], %[km], %[vv] row_newbcast:7 row_mask:0xf bank_mask:0xf\n\tv_fmac_f32_dpp %[y0], %[r], %[s0] row_newbcast:0 row_mask:0xf bank_mask:0xf\n\tv_fmac_f32_dpp %[y1], %[r], %[s1] row_newbcast:1 row_mask:0xf bank_mask:0xf\n\tv_fmac_f32_dpp %[y0], %[r], %[s2] row_newbcast:2 row_mask:0xf bank_mask:0xf\n\tv_fmac_f32_dpp %[y1], %[r], %[s3] row_newbcast:3 row_mask:0xf bank_mask:0xf\n\tv_fmac_f32_dpp %[y0], %[r], %[s4] row_newbcast:4 row_mask:0xf bank_mask:0xf\n\tv_fmac_f32_dpp %[y1], %[r], %[s5] row_newbcast:5 row_mask:0xf bank_mask:0xf\n\tv_fmac_f32_dpp %[y0], %[r], %[s6] row_newbcast:6 row_mask:0xf bank_mask:0xf\n\tv_fmac_f32_dpp %[y1], %[r], %[s7] row_newbcast:7 row_mask:0xf bank_mask:0xf" : [s0] "+v"(S[0]), [s1] "+v"(S[1]), [s2] "+v"(S[2]), [s3] "+v"(S[3]), [s4] "+v"(S[4]), [s5] "+v"(S[5]), [s6] "+v"(S[6]), [s7] "+v"(S[7]), [y0] "+v"(y0), [y1] "+v"(y1) : [d] "v"(dv), [ka] "v"(kav), [km] "v"(kmv), [r] "v"(rv), [nsa] "v"(nsa), [vv] "v"(vv))
#define SCAN_UPD_ASM_HI() asm("v_mul_f32_dpp %[s0], %[d], %[s0] row_newbcast:8 row_mask:0xf bank_mask:0xf\n\tv_mul_f32_dpp %[s1], %[d], %[s1] row_newbcast:9 row_mask:0xf bank_mask:0xf\n\tv_mul_f32_dpp %[s2], %[d], %[s2] row_newbcast:10 row_mask:0xf bank_mask:0xf\n\tv_mul_f32_dpp %[s3], %[d], %[s3] row_newbcast:11 row_mask:0xf bank_mask:0xf\n\tv_mul_f32_dpp %[s4], %[d], %[s4] row_newbcast:12 row_mask:0xf bank_mask:0xf\n\tv_mul_f32_dpp %[s5], %[d], %[s5] row_newbcast:13 row_mask:0xf bank_mask:0xf\n\tv_mul_f32_dpp %[s6], %[d], %[s6] row_newbcast:14 row_mask:0xf bank_mask:0xf\n\tv_mul_f32_dpp %[s7], %[d], %[s7] row_newbcast:15 row_mask:0xf bank_mask:0xf\n\tv_fmac_f32_dpp %[s0], %[ka], %[nsa] row_newbcast:8 row_mask:0xf bank_mask:0xf\n\tv_fmac_f32_dpp %[s1], %[ka], %[nsa] row_newbcast:9 row_mask:0xf bank_mask:0xf\n\tv_fmac_f32_dpp %[s2], %[ka], %[nsa] row_newbcast:10 row_mask:0xf bank_mask:0xf\n\tv_fmac_f32_dpp %[s3], %[ka], %[nsa] row_newbcast:11 row_mask:0xf bank_mask:0xf\n\tv_fmac_f32_dpp %[s4], %[ka], %[nsa] row_newbcast:12 row_mask:0xf bank_mask:0xf\n\tv_fmac_f32_dpp %[s5], %[ka], %[nsa] row_newbcast:13 row_mask:0xf bank_mask:0xf\n\tv_fmac_f32_dpp %[s6], %[ka], %[nsa] row_newbcast:14 row_mask:0xf bank_mask:0xf\n\tv_fmac_f32_dpp %[s7], %[ka], %[nsa] row_newbcast:15 row_mask:0xf bank_mask:0xf\n\tv_fmac_f32_dpp %[s0], %[km], %[vv] row_newbcast:8 row_mask:0xf bank_mask:0xf\n\tv_fmac_f32_dpp %[s1], %[km], %[vv] row_newbcast:9 row_mask:0xf bank_mask:0xf\n\tv_fmac_f32_dpp %[s2], %[km], %[vv] row_newbcast:10 row_mask:0xf bank_mask:0xf\n\tv_fmac_f32_dpp %[s3], %[km], %[vv] row_newbcast:11 row_mask:0xf bank_mask:0xf\n\tv_fmac_f32_dpp %[s4], %[km], %[vv] row_newbcast:12 row_mask:0xf bank_mask:0xf\n\tv_fmac_f32_dpp %[s5], %[km], %[vv] row_newbcast:13 row_mask:0xf bank_mask:0xf\n\tv_fmac_f32_dpp %[s6], %[km], %[vv] row_newbcast:14 row_mask:0xf bank_mask:0xf\n\tv_fmac_f32_dpp %[s7], %[km], %[vv] row_newbcast:15 row_mask:0xf bank_mask:0xf\n\tv_fmac_f32_dpp %[y0], %[r], %[s0] row_newbcast:8 row_mask:0xf bank_mask:0xf\n\tv_fmac_f32_dpp %[y1], %[r], %[s1] row_newbcast:9 row_mask:0xf bank_mask:0xf\n\tv_fmac_f32_dpp %[y0], %[r], %[s2] row_newbcast:10 row_mask:0xf bank_mask:0xf\n\tv_fmac_f32_dpp %[y1], %[r], %[s3] row_newbcast:11 row_mask:0xf bank_mask:0xf\n\tv_fmac_f32_dpp %[y0], %[r], %[s4] row_newbcast:12 row_mask:0xf bank_mask:0xf\n\tv_fmac_f32_dpp %[y1], %[r], %[s5] row_newbcast:13 row_mask:0xf bank_mask:0xf\n\tv_fmac_f32_dpp %[y0], %[r], %[s6] row_newbcast:14 row_mask:0xf bank_mask:0xf\n\tv_fmac_f32_dpp %[y1], %[r], %[s7] row_newbcast:15 row_mask:0xf bank_mask:0xf" : [s0] "+v"(S[8]), [s1] "+v"(S[9]), [s2] "+v"(S[10]), [s3] "+v"(S[11]), [s4] "+v"(S[12]), [s5] "+v"(S[13]), [s6] "+v"(S[14]), [s7] "+v"(S[15]), [y0] "+v"(y0), [y1] "+v"(y1) : [d] "v"(dv), [ka] "v"(kav), [km] "v"(kmv), [r] "v"(rv), [nsa] "v"(nsa), [vv] "v"(vv))
#define SCAN_STEP(cur, tcur) do { \
            float kkv = cur.k * kkc * cur.nv, kav = kkv * cur.a, kmv = cur.k + cur.k * (cur.a - 1.0f) * kac, dv = cur.d, rv = cur.r; \
            const float vv = cur.v; \
            asm volatile("s_nop 1" : "+v"(kkv), "+v"(kav), "+v"(kmv), "+v"(dv), "+v"(rv)); \
            float sa0 = 0.f, sa1 = 0.f; \
            SCAN_SA_ASM(); \
            const float nsa = -segsum(sa0 + sa1); \
            float y0 = 0.f, y1 = 0.f; \
            SCAN_UPD_ASM_LO(); SCAN_UPD_ASM_HI(); \
            const float y = segsum(y0 + y1); \
            if (F.lane < 16) Y[(size_t)(rfirst + rstep * (tcur)) * CW + vcol] = y; } while (0)
    ScanIn bA[4], bB[4];
    SCAN_LOAD(bA[0], 0); SCAN_LOAD(bA[1], 1); SCAN_LOAD(bA[2], 2); SCAN_LOAD(bA[3], 3);
    for (int t = 0; t < L; t += 8) {
#pragma unroll
        for (int u = 0; u < 4; ++u) { SCAN_LOAD(bB[u], t + u + 4); SCAN_STEP(bA[u], t + u); }
#pragma unroll
        for (int u = 0; u < 4; ++u) { SCAN_LOAD(bA[u], t + u + 8); SCAN_STEP(bB[u], t + u + 4); }
    }
#undef SCAN_STEP
#undef SCAN_SA_ASM
#undef SCAN_UPD_ASM_LO
#undef SCAN_UPD_ASM_HI
    }
    __builtin_amdgcn_s_setprio(0);
#undef SCAN_LOAD
    if (!lat) {
        float* so = p->out + (size_t)M * D + srow;
#pragma unroll
        for (int j = 0; j < 4; ++j) *(f32x4*)(so + 4 * j) = (f32x4){S[4 * j], S[4 * j + 1], S[4 * j + 2], S[4 * j + 3]};
    }
}
__device__ __forceinline__ void fnet_seq_job(const Frame& F, CParams p, int v, bool lat) {
    unsigned char* ws = p->ws;
    const int fr = F.lane & 15, fq = F.lane >> 4;
    int K2, seqrow0, mt, nt; const bf16_t* tb; const bf16_t* dft;
    if (lat) { const int b = v >> 7; mt = (v >> 3) & 15; nt = v & 7; K2 = 2048; seqrow0 = MC + b * 1024; dft = (const bf16_t*)(ws + WS_DFTL);
        tb = (const bf16_t*)(ws + WS_TTB) + (size_t)32 * 4 * 128 * 512 + (size_t)b * 512 * 2048; }
    else { const int b = v >> 5; mt = (v >> 3) & 3; nt = v & 7; K2 = 512; seqrow0 = b * 256; dft = (const bf16_t*)(ws + WS_DFTC);
        tb = (const bf16_t*)(ws + WS_TTB) + (size_t)b * 512 * 512; }
    const int rs = (K2 >> 5) * 512;
    const bf16_t* pp = tb + (size_t)(4 * nt) * rs + F.lane * 8;
    const bf16_t* qp = dft + (size_t)(4 * mt) * rs + F.lane * 8;
    f32x4 acc[4][4];
#pragma unroll
    for (int a = 0; a < 4; ++a)
#pragma unroll
        for (int b = 0; b < 4; ++b) acc[a][b] = (f32x4){0.f, 0.f, 0.f, 0.f};
    bf16x8 pf[4], qf[4], pn[4], qn[4];
#pragma unroll
    for (int i = 0; i < 4; ++i) { pf[i] = *(const bf16x8*)(pp + (size_t)i * rs); qf[i] = *(const bf16x8*)(qp + (size_t)i * rs); }
    const int nks = K2 / 32;
    for (int ks = 0; ks < nks; ++ks) {
        const int kn = (ks + 1 < nks) ? (ks + 1) * 512 : 0;
#pragma unroll
        for (int i = 0; i < 4; ++i) { pn[i] = *(const bf16x8*)(pp + (size_t)i * rs + kn); qn[i] = *(const bf16x8*)(qp + (size_t)i * rs + kn); }
#pragma unroll
        for (int ni = 0; ni < 4; ++ni)
#pragma unroll
            for (int ti = 0; ti < 4; ++ti) acc[ni][ti] = MFMA16(pf[ni], qf[ti], acc[ni][ti]);
#pragma unroll
        for (int i = 0; i < 4; ++i) { pf[i] = pn[i]; qf[i] = qn[i]; }
    }
    bf16_t* MIX = (bf16_t*)(ws + WS_H);
#pragma unroll
    for (int ti = 0; ti < 4; ++ti) {
        const int mrow = seqrow0 + 64 * mt + 16 * ti + fr;
#pragma unroll
        for (int ni = 0; ni < 4; ++ni) { const f32x4 x = acc[ni][ti]; u32x2 w; w.x = pk2(x.x, x.y); w.y = pk2(x.z, x.w); *(u32x2*)(MIX + pg8::blk_off(mrow, 512 + 64 * nt + 4 * fq + 16 * ni, D)) = w; }
    }
}
__device__ __forceinline__ void sgu_job(const Frame& F, CParams p, int l, int v) {
    unsigned char* ws = p->ws;
    const int fr = F.lane & 15, fq = F.lane >> 4;
    const int chunk = v >> 4, h = (v >> 2) & 3, tt = (v >> 1) & 1, dt = v & 1;
    const bf16_t* pp = (const bf16_t*)(ws + WS_VNT) + ((size_t)chunk * 512 + h * 128 + 64 * dt + fr) * 128 + 8 * fq;
    const bf16_t* qp = (const bf16_t*)(ws + WS_SGUW) + ((size_t)(l * 4 + h) * 128 + 64 * tt + fr) * 128 + 8 * fq;
    f32x4 acc[4][4];
#pragma unroll
    for (int a = 0; a < 4; ++a)
#pragma unroll
        for (int b = 0; b < 4; ++b) acc[a][b] = (f32x4){0.f, 0.f, 0.f, 0.f};
#pragma unroll
    for (int ks = 0; ks < 4; ++ks) {
        bf16x8 pf[4], qf[4];
#pragma unroll
        for (int i = 0; i < 4; ++i) { pf[i] = *(const bf16x8*)(pp + (size_t)(16 * i) * 128 + 32 * ks); qf[i] = *(const bf16x8*)(qp + (size_t)(16 * i) * 128 + 32 * ks); }
#pragma unroll
        for (int di = 0; di < 4; ++di)
#pragma unroll
            for (int ti = 0; ti < 4; ++ti) acc[di][ti] = MFMA16(pf[di], qf[ti], acc[di][ti]);
    }
    const bf16_t* U = (const bf16_t*)(ws + WS_U); bf16_t* MIX = (bf16_t*)(ws + WS_H);
#pragma unroll
    for (int ti = 0; ti < 4; ++ti) {
        const int t = 64 * tt + 16 * ti + fr, token = chunk * 128 + t;
        const float bias = p->sgu_b[(l * 4 + h) * 128 + t];
#pragma unroll
        for (int di = 0; di < 4; ++di) {
            const int ch = h * 128 + 64 * dt + 16 * di + 4 * fq;
            const u32x2 uu = *(const u32x2*)(U + (size_t)token * 512 + ch);
            const f32x4 x = acc[di][ti] + bias;
            const float u0 = __uint_as_float(uu.x << 16), u1 = __uint_as_float(uu.x & 0xffff0000u), u2 = __uint_as_float(uu.y << 16), u3 = __uint_as_float(uu.y & 0xffff0000u);
            u32x2 w; w.x = pk2(u0 * x.x, u1 * x.y); w.y = pk2(u2 * x.z, u3 * x.w);
            *(u32x2*)(MIX + pg8::blk_off(token, ch, D)) = w;
        }
    }
}
typedef short bf16x4 __attribute__((ext_vector_type(4)));
#define MFMA16K(a, b, c) MFMA16(cat44z(a), cat44z(b), (c))
__device__ __forceinline__ bf16x4 pack4(f32x4 x) { u32x2 w; w.x = pk2(x.x, x.y); w.y = pk2(x.z, x.w); return __builtin_bit_cast(bf16x4, w); }
__device__ __forceinline__ bf16x8 pack8(f32x4 lo, f32x4 hi) { u32x4 w; w.x = pk2(lo.x, lo.y); w.y = pk2(lo.z, lo.w); w.z = pk2(hi.x, hi.y); w.w = pk2(hi.z, hi.w); return __builtin_bit_cast(bf16x8, w); }
__device__ __forceinline__ bf16x8 cat44(bf16x4 a, bf16x4 b) { const u32x2 x = __builtin_bit_cast(u32x2, a), y = __builtin_bit_cast(u32x2, b); u32x4 w; w.x = x.x; w.y = x.y; w.z = y.x; w.w = y.y; return __builtin_bit_cast(bf16x8, w); }
__device__ __forceinline__ bf16x8 cat44z(bf16x4 a) { const u32x2 x = __builtin_bit_cast(u32x2, a); u32x4 w; w.x = x.x; w.y = x.y; w.z = 0u; w.w = 0u; return __builtin_bit_cast(bf16x8, w); }
template <int CTRL> __device__ __forceinline__ float dppf(float x) { return __builtin_bit_cast(float, __builtin_amdgcn_update_dpp(0, __builtin_bit_cast(int, x), CTRL, 0xf, 0xf, true)); }
__device__ __forceinline__ float prefix16(float x) {
    x += dppf<0x111>(x); x += dppf<0x112>(x); x += dppf<0x114>(x); x += dppf<0x118>(x); return x;
}
__device__ __forceinline__ f32x4 prefix16v(f32x4 x) { f32x4 r; r.x = prefix16(x.x); r.y = prefix16(x.y); r.z = prefix16(x.z); r.w = prefix16(x.w); return r; }
__device__ __forceinline__ f32x4 bcast15v(f32x4 x) { f32x4 r; r.x = dppf<0x15f>(x.x); r.y = dppf<0x15f>(x.y); r.z = dppf<0x15f>(x.z); r.w = dppf<0x15f>(x.w); return r; }
__device__ __forceinline__ f32x4 expv(f32x4 x) { f32x4 r; r.x = __expf(x.x); r.y = __expf(x.y); r.z = __expf(x.z); r.w = __expf(x.w); return r; }

struct ChunkPrep { bf16x8 KtF0; bf16x4 AkkP; bf16x8 KtF1; bf16x4 N8; bf16x8 RtF0; bf16x4 N4; bf16x8 RtF1; bf16x4 N2; bf16x8 ARp; bf16x4 Nn; };
struct ChunkCtx { const float *R, *Kb, *V, *Wd, *A, *INVN, *kk, *ka; float* Y; int rfirst, rstep, h, fr, fq, chb; };
struct ChunkConst { const LAS float* tab; };
template <int NVT> struct ChunkRaw { f32x4 k[4], r[4], a[4], w[4]; f32x4 v[NVT]; float nv; };
template <int NVT> __device__ __forceinline__ void chunk_load(const ChunkCtx& C, int c0, int vt0, ChunkRaw<NVT>& W) {
    const int fr = C.fr, fq = C.fq;
    const size_t rrow = (size_t)(C.rfirst + C.rstep * (c0 + fr));
    const size_t rt = rrow * CW + C.chb;
    W.nv = C.INVN[rrow * 16 + C.h];
#pragma unroll
    for (int q = 0; q < 4; ++q) { const int co = 16 * q;
        W.k[q] = *(const f32x4*)(C.Kb + rt + co); W.r[q] = *(const f32x4*)(C.R + rt + co); W.a[q] = *(const f32x4*)(C.A + rt + co); W.w[q] = *(const f32x4*)(C.Wd + rt + co); }
#pragma unroll
    for (int j = 0; j < 4; ++j) { const size_t ri = (size_t)(C.rfirst + C.rstep * (c0 + 4 * fq + j)) * CW + C.h * 64 + fr;
#pragma unroll
        for (int vi = 0; vi < NVT; ++vi) W.v[vi][j] = C.V[ri + 16 * (vt0 + vi)]; }
}
constexpr int RING_SLOT = 17664;
template <int NVT> __device__ __forceinline__ void chunk_dma(const ChunkCtx& C, int c0, int vt0, LAS unsigned char* slot) {
    const int fr = C.fr, fq = C.fq;
    const size_t rrow = (size_t)(C.rfirst + C.rstep * (c0 + fr));
    const size_t rt = rrow * CW + C.chb;
#pragma unroll
    for (int q = 0; q < 4; ++q) {
        __builtin_amdgcn_global_load_lds((const unsigned*)(C.Kb + rt + 16 * q), (LAS unsigned*)(slot + (0 + q) * 1024), 16, 0, 0);
        __builtin_amdgcn_global_load_lds((const unsigned*)(C.R + rt + 16 * q), (LAS unsigned*)(slot + (4 + q) * 1024), 16, 0, 0);
        __builtin_amdgcn_global_load_lds((const unsigned*)(C.A + rt + 16 * q), (LAS unsigned*)(slot + (8 + q) * 1024), 16, 0, 0);
        __builtin_amdgcn_global_load_lds((const unsigned*)(C.Wd + rt + 16 * q), (LAS unsigned*)(slot + (12 + q) * 1024), 16, 0, 0);
    }
#pragma unroll
    for (int j = 0; j < 4; ++j) { const size_t ri = (size_t)(C.rfirst + C.rstep * (c0 + 4 * fq + j)) * CW + C.h * 64 + fr + 16 * vt0;
#pragma unroll
        for (int vi = 0; vi < NVT; ++vi) __builtin_amdgcn_global_load_lds((const unsigned*)(C.V + ri + 16 * vi), (LAS unsigned*)(slot + 16384 + (vi * 4 + j) * 256), 4, 0, 0); }
    __builtin_amdgcn_global_load_lds((const unsigned*)(C.INVN + rrow * 16 + C.h), (LAS unsigned*)(slot + 16384 + NVT * 1024), 4, 0, 0);
}
__device__ __forceinline__ void chunk_unpark(const LAS unsigned char* slot, int lane, ChunkRaw<1>& W) {
#pragma unroll
    for (int q = 0; q < 4; ++q) {
        W.k[q] = *(const LAS f32x4*)(slot + (0 + q) * 1024 + lane * 16); W.r[q] = *(const LAS f32x4*)(slot + (4 + q) * 1024 + lane * 16);
        W.a[q] = *(const LAS f32x4*)(slot + (8 + q) * 1024 + lane * 16); W.w[q] = *(const LAS f32x4*)(slot + (12 + q) * 1024 + lane * 16); }
#pragma unroll
    for (int j = 0; j < 4; ++j) W.v[0][j] = *(const LAS float*)(slot + 16384 + j * 256 + lane * 4);
    W.nv = *(const LAS float*)(slot + 16384 + 1024 + lane * 4);
}
template <int NVT, int SRC> __device__ __forceinline__ void chunk_prep(const ChunkCtx& C, const ChunkConst& K, const ChunkRaw<NVT>& W, const LAS unsigned char* slot, int c0, int vt0, LAS bf16_t* TK, LAS float* FD, ChunkPrep& P, bf16x4 (&Vp)[NVT]) {
    constexpr bool RAW = (SRC == 1);
    LAS bf16_t* TB = TK + 1024;
    const int fr = C.fr, fq = C.fq, F_lane = 16 * C.fq + C.fr;
    const size_t rrow = (size_t)(C.rfirst + C.rstep * (c0 + fr));
    const size_t rt = rrow * CW + C.chb;
    float nv; if constexpr (SRC == 1) nv = W.nv; else if constexpr (SRC == 2) nv = *(const LAS float*)(slot + 16384 + NVT * 1024 + F_lane * 4); else nv = C.INVN[rrow * 16 + C.h];
    bf16x8 KhF[2], BhF[2], KtFl[2], RtFl[2];
#pragma unroll
    for (int ks = 0; ks < 2; ++ks) {
        f32x4 Kt[2], Kh[2], Bh[2], Rt[2];
#pragma unroll
        for (int hh = 0; hh < 2; ++hh) {
            const int co = 32 * ks + 16 * hh;
            f32x4 kx, rx, ax, wx;
            if constexpr (SRC == 1) { kx = W.k[2 * ks + hh]; rx = W.r[2 * ks + hh]; ax = W.a[2 * ks + hh]; wx = W.w[2 * ks + hh]; }
            else if constexpr (SRC == 2) { const int q = 2 * ks + hh; kx = *(const LAS f32x4*)(slot + (0 + q) * 1024 + F_lane * 16); rx = *(const LAS f32x4*)(slot + (4 + q) * 1024 + F_lane * 16);
                ax = *(const LAS f32x4*)(slot + (8 + q) * 1024 + F_lane * 16); wx = *(const LAS f32x4*)(slot + (12 + q) * 1024 + F_lane * 16); }
            else { kx = *(const f32x4*)(C.Kb + rt + co); rx = *(const f32x4*)(C.R + rt + co); ax = *(const f32x4*)(C.A + rt + co); wx = *(const f32x4*)(C.Wd + rt + co); }
            f32x4 kkc, kac;
            if constexpr (SRC != 0) { kkc = *(const LAS f32x4*)(K.tab + fq * 32 + 4 * (2 * ks + hh)); kac = *(const LAS f32x4*)(K.tab + fq * 32 + 16 + 4 * (2 * ks + hh)); } else { kkc = *(const f32x4*)(C.kk + C.chb + co); kac = *(const f32x4*)(C.ka + C.chb + co); }
            const f32x4 kap = kx * kkc * nv, bet = kap * ax, kbar = kx + kx * (ax - 1.0f) * kac;
            f32x4 e1, e2, e0;
#pragma unroll
            for (int j = 0; j < 4; ++j) { e1[j] = __builtin_amdgcn_exp2f(-wx[j]); e2[j] = __builtin_amdgcn_exp2f(wx[j]); }
            e0 = dppv<0x111>(e1);
            if (fr == 0) e0 = (f32x4){1.f, 1.f, 1.f, 1.f};
            Kt[hh] = kap * e0; Kh[hh] = kbar * e2; Bh[hh] = bet * e2; Rt[hh] = rx * e1;
            *(LAS f32x4*)(fr == 15 ? FD + fq * 16 + 8 * ks + 4 * hh : FD + 64) = e1;
#pragma unroll
            for (int j = 0; j < 4; ++j) { const int prow = co + 4 * j + fq;
                TK[prow * 16 + fr] = (bf16_t)(pk2(Kh[hh][j], 0.f) & 0xffffu); TB[prow * 16 + fr] = (bf16_t)(pk2(Bh[hh][j], 0.f) & 0xffffu); }
        }
        KtFl[ks] = pack8(Kt[0], Kt[1]); KhF[ks] = pack8(Kh[0], Kh[1]); BhF[ks] = pack8(Bh[0], Bh[1]); RtFl[ks] = pack8(Rt[0], Rt[1]);
    }
    const f32x4 z4 = (f32x4){0.f, 0.f, 0.f, 0.f};
    f32x4 AkkL1 = z4, AkbL1 = z4, AkbL2 = z4, ArkL1 = z4, ArbL1 = z4;
#pragma unroll
    for (int ks = 0; ks < 2; ++ks) {
        AkkL1 = MFMA16(KhF[ks], KtFl[ks], AkkL1); AkbL1 = MFMA16(BhF[ks], KtFl[ks], AkbL1); AkbL2 = MFMA16(KtFl[ks], BhF[ks], AkbL2);
        ArkL1 = MFMA16(KhF[ks], RtFl[ks], ArkL1); ArbL1 = MFMA16(BhF[ks], RtFl[ks], ArbL1);
    }
    P.KtF0 = KtFl[0]; P.KtF1 = KtFl[1]; P.RtF0 = RtFl[0]; P.RtF1 = RtFl[1];
#pragma unroll
    for (int j = 0; j < 4; ++j) { const int ci = 4 * fq + j;
        if (!(ci < fr)) { AkkL1[j] = 0.f; AkbL1[j] = 0.f; }
        if (!(fr < ci)) AkbL2[j] = 0.f;
        if (!(ci <= fr)) { ArkL1[j] = 0.f; ArbL1[j] = 0.f; } }
    P.AkkP = pack4(AkkL1); P.ARp = cat44(pack4(ArkL1), pack4(ArbL1));
    const bf16x4 N1L1 = pack4(AkbL1), N1L2 = pack4(AkbL2);
    const f32x4 N2L2f = MFMA16K(N1L1, N1L2, z4), N2L1f = MFMA16K(N1L2, N1L1, z4);
    const bf16x4 N2L1 = pack4(N2L1f), N2L2 = pack4(N2L2f);
    const f32x4 N4L2f = MFMA16K(N2L1, N2L2, z4), N4L1f = MFMA16K(N2L2, N2L1, z4);
    const bf16x4 N4L1 = pack4(N4L1f), N4L2 = pack4(N4L2f);
    P.N8 = pack4(MFMA16K(N4L2, N4L1, z4)); P.N4 = N4L1; P.N2 = N2L1; P.Nn = pack4(-AkbL1);
#pragma unroll
    for (int vi = 0; vi < NVT; ++vi) {
        if constexpr (SRC == 1) Vp[vi] = pack4(W.v[vi]);
        else if constexpr (SRC == 2) { f32x4 t4;
#pragma unroll
            for (int j = 0; j < 4; ++j) t4[j] = *(const LAS float*)(slot + 16384 + (vi * 4 + j) * 256 + F_lane * 4);
            Vp[vi] = pack4(t4); }
        else { f32x4 t4;
#pragma unroll
            for (int j = 0; j < 4; ++j) t4[j] = C.V[(size_t)(C.rfirst + C.rstep * (c0 + 4 * fq + j)) * CW + C.h * 64 + fr + 16 * (vt0 + vi)];
            Vp[vi] = pack4(t4); }
    }
}
template <int NVT, bool DEFER = false> __device__ __forceinline__ void chunk_chain(const ChunkCtx& C, int c0, int vt0, const LAS bf16_t* TK, const LAS float* FD, const ChunkPrep& P, const bf16x4 (&Vp)[NVT], f32x4 (&Sacc)[4][NVT], f32x4* ydef = nullptr) {
    const LAS bf16_t* TB = TK + 1024;
    const int fr = C.fr, fq = C.fq;
    const f32x4 z4 = (f32x4){0.f, 0.f, 0.f, 0.f};
    size_t rowi[4];
#pragma unroll
    for (int j = 0; j < 4; ++j) rowi[j] = (size_t)(C.rfirst + C.rstep * (c0 + 4 * fq + j)) * CW + C.h * 64 + fr;
    bf16x8 VW[NVT];
#pragma unroll
    for (int vi = 0; vi < NVT; ++vi) {
        const bf16x8 s0 = pack8(Sacc[0][vi], Sacc[1][vi]), s1 = pack8(Sacc[2][vi], Sacc[3][vi]);
        f32x4 x = z4; x = MFMA16(P.KtF0, s0, x); x = MFMA16(P.KtF1, s1, x); x = MFMA16K(P.AkkP, Vp[vi], x); x = -x;
        f32x4 y = z4; y = MFMA16(P.RtF0, s0, y); y = MFMA16(P.RtF1, s1, y);
        x = MFMA16K(P.N8, pack4(x), x); x = MFMA16K(P.N4, pack4(x), x); x = MFMA16K(P.N2, pack4(x), x); x = MFMA16K(P.Nn, pack4(x), x);
        VW[vi] = cat44(Vp[vi], pack4(x));
        y = MFMA16(P.ARp, VW[vi], y);
        const int vo = 16 * (vt0 + vi);
        if constexpr (DEFER) ydef[vi] = y;
        else { C.Y[rowi[0] + vo] = y.x; C.Y[rowi[1] + vo] = y.y; C.Y[rowi[2] + vo] = y.z; C.Y[rowi[3] + vo] = y.w; }
    }
#pragma unroll
    for (int kt = 0; kt < 4; ++kt) {
        const int prow = 16 * kt + 4 * (fr & 3) + (fr >> 2);
        const bf16x4 pk_ = *(const LAS bf16x4*)(TK + prow * 16 + 4 * fq), pb_ = *(const LAS bf16x4*)(TB + prow * 16 + 4 * fq);
        const bf16x8 SUP = cat44(pk_, pb_);
        const f32x4 fd = *(const LAS f32x4*)(FD + fq * 16 + 4 * kt);
#pragma unroll
        for (int vi = 0; vi < NVT; ++vi) Sacc[kt][vi] = MFMA16(SUP, VW[vi], Sacc[kt][vi]) * fd;
    }
}
template <int NVT, int MODE> __device__ __forceinline__ void scan_chunk_job(const Frame& F, CParams p, int l, int chain, int vt0, bool lat, LAS unsigned char* wbase) {
    unsigned char* ws = p->ws;
    const int b = chain >> 5, h = (chain & 31) >> 1, dir = chain & 1;
    const int L = lat ? 1024 : 256, base = lat ? MC + b * 1024 : b * 256;
    ChunkCtx C;
    C.fr = F.lane & 15; C.fq = F.lane >> 4; C.h = h; C.chb = h * 64 + 4 * C.fq;
    C.R = (const float*)(ws + WS_SC); C.Kb = C.R + (size_t)M * CW; C.V = C.Kb + (size_t)M * CW;
    C.Wd = C.R + (size_t)(3 + dir) * M * CW; C.A = C.R + (size_t)(5 + dir) * M * CW;
    C.INVN = (const float*)(ws + WS_INVN);
    C.Y = (float*)(ws + WS_Z) + (size_t)dir * M * CW;
    C.kk = p->k_k + l * CW; C.ka = p->k_a + l * CW;
    C.rstep = dir ? -1 : 1; C.rfirst = dir ? base + L - 1 : base;
    const size_t srow = (size_t)(((b * 2 + l) * 2 + dir) * 16 + h) * 4096;
    const int fr = C.fr, fq = C.fq;
    f32x4 Sacc[4][NVT];
    if (lat) {
        const float* s0 = p->state_wkv + srow;
#pragma unroll
        for (int kt = 0; kt < 4; ++kt)
#pragma unroll
            for (int vi = 0; vi < NVT; ++vi) Sacc[kt][vi] = *(const f32x4*)(s0 + (16 * (vt0 + vi) + fr) * 64 + 16 * kt + 4 * fq);
    } else {
#pragma unroll
        for (int kt = 0; kt < 4; ++kt)
#pragma unroll
            for (int vi = 0; vi < NVT; ++vi) Sacc[kt][vi] = (f32x4){0.f, 0.f, 0.f, 0.f};
    }
    ChunkConst KC; KC.tab = (const LAS float*)(F.lds + LDS_MISC + 1024 + (F.wave < 6 ? F.wave : F.wave - 2) * 512);
    if (MODE != 0) {
        LAS float* tw = (LAS float*)(F.lds + LDS_MISC + 1024 + (F.wave < 6 ? F.wave : F.wave - 2) * 512) + fq * 32;
        if (fr == 0) {
#pragma unroll
            for (int q = 0; q < 4; ++q) { *(LAS f32x4*)(tw + 4 * q) = *(const f32x4*)(C.kk + C.chb + 16 * q); *(LAS f32x4*)(tw + 16 + 4 * q) = *(const f32x4*)(C.ka + C.chb + 16 * q); }
        }
    }
    if (lat) __builtin_amdgcn_s_setprio(LAT_PRIO);
    ChunkRaw<NVT> Rw;
    if constexpr (MODE == 1) {
        LAS bf16_t* T0 = (LAS bf16_t*)wbase; LAS float* FD0 = (LAS float*)(wbase + 8192); LAS unsigned char* ring = wbase + 9216;
        ChunkPrep P; bf16x4 Vp[NVT];
        chunk_dma<NVT>(C, 0, vt0, ring);
        asm volatile("s_waitcnt vmcnt(0)" ::: "memory");
        chunk_unpark(ring, F.lane, Rw);
        asm volatile("s_waitcnt lgkmcnt(0)" ::: "memory");
        chunk_dma<NVT>(C, 16, vt0, ring);
        chunk_prep<NVT, 1>(C, KC, Rw, ring, 0, vt0, T0, FD0, P, Vp);
#pragma unroll 1
        for (int c0 = 0; c0 < L; c0 += 16) {
            const int par = (c0 >> 4) & 1, cn = (c0 + 32 < L) ? c0 + 32 : L - 16;
            f32x4 yv[NVT];
            chunk_chain<NVT, true>(C, c0, vt0, T0 + par * 2048, FD0 + par * 80, P, Vp, Sacc, yv);
            __builtin_amdgcn_sched_barrier(0);
            asm volatile("s_waitcnt vmcnt(0)" ::: "memory");
            chunk_unpark(ring, F.lane, Rw);
            asm volatile("s_waitcnt lgkmcnt(0)" ::: "memory");
#pragma unroll
            for (int vi = 0; vi < NVT; ++vi) {
#pragma unroll
                for (int j = 0; j < 4; ++j) C.Y[(size_t)(C.rfirst + C.rstep * (c0 + 4 * fq + j)) * CW + C.h * 64 + fr + 16 * (vt0 + vi)] = yv[vi][j];
            }
            chunk_dma<NVT>(C, cn, vt0, ring);
#ifdef DBG_DMA2
            __builtin_amdgcn_sched_barrier(0);
            chunk_dma<NVT>(C, cn, vt0, ring);
#endif
            __builtin_amdgcn_sched_barrier(0);
            ChunkPrep Pn; bf16x4 Vn[NVT];
            chunk_prep<NVT, 1>(C, KC, Rw, ring, c0 + 16, vt0, T0 + (par ^ 1) * 2048, FD0 + (par ^ 1) * 80, Pn, Vn);
            __builtin_amdgcn_sched_barrier(0);
            P = Pn;
#pragma unroll
            for (int vi = 0; vi < NVT; ++vi) Vp[vi] = Vn[vi];
        }
    } else if constexpr (MODE == 2) {
        LAS bf16_t* T0 = (LAS bf16_t*)wbase; LAS float* FD0 = (LAS float*)(wbase + 4096); LAS unsigned char* ring = wbase + 4608;
        chunk_dma<NVT>(C, 0, vt0, ring);
        f32x4 yv[NVT]; bool havey = false;
#pragma unroll 1
        for (int c0 = 0; c0 < L; c0 += 16) {
            const int cn = (c0 + 16 < L) ? c0 + 16 : c0;
            asm volatile("s_waitcnt vmcnt(0)" ::: "memory");
            ChunkPrep P; bf16x4 Vp[NVT];
            chunk_prep<NVT, 2>(C, KC, Rw, ring, c0, vt0, T0, FD0, P, Vp);
            asm volatile("s_waitcnt lgkmcnt(0)" ::: "memory");
            __builtin_amdgcn_sched_barrier(0);
            if (havey) {
#pragma unroll
                for (int vi = 0; vi < NVT; ++vi) {
#pragma unroll
                    for (int j = 0; j < 4; ++j) C.Y[(size_t)(C.rfirst + C.rstep * (c0 - 16 + 4 * fq + j)) * CW + C.h * 64 + fr + 16 * (vt0 + vi)] = yv[vi][j];
                }
            }
            chunk_dma<NVT>(C, cn, vt0, ring);
            __builtin_amdgcn_sched_barrier(0);
            chunk_chain<NVT, true>(C, c0, vt0, T0, FD0, P, Vp, Sacc, yv);
            havey = true;
        }
        asm volatile("s_waitcnt vmcnt(0)" ::: "memory");
#pragma unroll
        for (int vi = 0; vi < NVT; ++vi) {
#pragma unroll
            for (int j = 0; j < 4; ++j) C.Y[(size_t)(C.rfirst + C.rstep * (L - 16 + 4 * fq + j)) * CW + C.h * 64 + fr + 16 * (vt0 + vi)] = yv[vi][j];
        }
    } else {
        LAS bf16_t* T0 = (LAS bf16_t*)wbase; LAS float* FD0 = (LAS float*)(wbase + 4096);
#pragma unroll 1
        for (int c0 = 0; c0 < L; c0 += 16) {
            ChunkPrep P; bf16x4 Vp[NVT];
            chunk_prep<NVT, 0>(C, KC, Rw, wbase, c0, vt0, T0, FD0, P, Vp);
            chunk_chain<NVT>(C, c0, vt0, T0, FD0, P, Vp, Sacc);
        }
    }
    __builtin_amdgcn_s_setprio(0);
    if (!lat) {
        float* so = p->out + (size_t)M * D + srow;
#pragma unroll
        for (int kt = 0; kt < 4; ++kt)
#pragma unroll
            for (int vi = 0; vi < NVT; ++vi) *(f32x4*)(so + (16 * (vt0 + vi) + fr) * 64 + 16 * kt + 4 * fq) = Sacc[kt][vi];
    }
}
__device__ __forceinline__ void seqmix_phase(const Frame& F, CParams p, int l, int rep, int part = 3) {
    unsigned* ctr = (unsigned*)(p->ws + WS_CTL) + CW_JOB + 64 * (l + 2 * rep);
#if SCAN_CHUNKED
    constexpr int J_SCAN = 512 + 1024, J_FL = J_SCAN + 512, J_FC = J_FL + 1024, NJ = J_FC + 1536;
    const bool static_all = (F.G == 256);
    if (part & 1) {
        if (static_all) {
#ifndef DBG_SCAN_SEL
#define DBG_SCAN_SEL 3
#endif
            if (F.wave < 2) { if (rep == 0 || !(part & 4) || (DBG_SCAN_SEL & 1)) { const int q = 2 * F.bid + F.wave; scan_chunk_job<1, 1>(F, p, l, q >> 2, q & 3, true, F.lds + F.wave * 26880); } }
#ifndef CTX_WAVES_HI
#define CTX_WAVES_HI 1
#endif
            else if (CTX_WAVES_HI ? (F.wave & 2) != 0 : F.wave < 6) {
                const int ci = CTX_WAVES_HI ? (F.wave & 1) + (F.wave >> 2) * 2 : F.wave - 2;
                if (rep == 0 || !(part & 4) || (DBG_SCAN_SEL & 2)) scan_chunk_job<4, 2>(F, p, l, 4 * F.bid + ci, 0, false, F.lds + 53760 + ci * 25344); }
        }
    }
    if (!(part & 2)) return;
    for (int rq = 0; rq < DBG_DUP_Q; ++rq)
    for (;;) {
        unsigned j = 0;
        if (F.lane == 0) j = __hip_atomic_fetch_add(ctr + 128 * rq, 1u, __ATOMIC_RELAXED, __HIP_MEMORY_SCOPE_AGENT);
        const int job = (int)__builtin_amdgcn_readfirstlane(j) + (static_all ? J_SCAN : 0);
        if (job >= NJ) break;
        if (job < 512) scan_chunk_job<1, 0>(F, p, l, job >> 2, job & 3, true, F.lds + F.wave * 8192);
        else if (job < J_SCAN) scan_chunk_job<4, 0>(F, p, l, job - 512, 0, false, F.lds + F.wave * 8192);
#else
    constexpr int J_SCAN = 512 + 4096, J_FL = J_SCAN + 512, J_FC = J_FL + 1024, NJ = J_FC + 1536;
    const bool static_lat = (F.G == 256);
    if (static_lat && F.wave < 2) scan_job(F, p, l, 2 * F.bid + F.wave);
    for (;;) {
        unsigned j = 0;
        if (F.lane == 0) j = __hip_atomic_fetch_add(ctr, 1u, __ATOMIC_RELAXED, __HIP_MEMORY_SCOPE_AGENT);
        const int job = (int)__builtin_amdgcn_readfirstlane(j) + (static_lat ? 512 : 0);
        if (job >= NJ) break;
        if (job < J_SCAN) scan_job(F, p, l, job);
#endif
        else if (job < J_FL) { if (rq == 0 || (DBG_DUP_SEL & 2)) fnet_seq_job(F, p, job - J_SCAN, true); }
        else if (job < J_FC) { if (rq == 0 || (DBG_DUP_SEL & 4)) fnet_seq_job(F, p, job - J_FL, false); }
        else { if (rq == 0 || (DBG_DUP_SEL & 8)) sgu_job(F, p, l, job - J_FC); }
    }
}

__device__ __forceinline__ void post_phase(const Frame& F, CParams p, int l) {
    unsigned char* ws = p->ws;
#if FNET_IN_POST
    {
        unsigned* ctr = (unsigned*)(ws + WS_CTL) + CW_JOB + 64 * (8 + l);
        for (;;) {
            unsigned j = 0;
            if (F.lane == 0) j = __hip_atomic_fetch_add(ctr, 1u, __ATOMIC_RELAXED, __HIP_MEMORY_SCOPE_AGENT);
            const int job = (int)__builtin_amdgcn_readfirstlane(j);
            if (job >= 512 + 1024 + 1536) break;
            if (job < 512) fnet_seq_job(F, p, job, true);
            else if (job < 1536) fnet_seq_job(F, p, job - 512, false);
            else sgu_job(F, p, l, job - 1536);
        }
    }
#endif
    const float* R = (const float*)(ws + WS_SC); const float* Kb = R + (size_t)M * CW; const float* V = Kb + (size_t)M * CW;
    const float* A0 = R + (size_t)5 * M * CW; const float* A1 = R + (size_t)6 * M * CW;
    const float* Y0 = (const float*)(ws + WS_Z); const float* Y1 = Y0 + (size_t)M * CW;
    const bf16_t* G = (const bf16_t*)(ws + WS_G); bf16_t* MIX = (bf16_t*)(ws + WS_H);
    const int gw = F.bid * NWAVES + F.wave, NGW = F.G * NWAVES;
    for (int row = gw; row < M; row += NGW) {
#pragma unroll
        for (int i = 0; i < 4; ++i) {
            const int ch = 4 * F.lane + 256 * i; const size_t o = (size_t)row * CW + ch;
            const f32x4 y = *(const f32x4*)(Y0 + o) + *(const f32x4*)(Y1 + o);
            const float mu = sum16((y.x + y.y) + (y.z + y.w)) * (1.0f / 64.0f);
            const f32x4 d = y - mu;
            const float var = sum16((d.x * d.x + d.y * d.y) + (d.z * d.z + d.w * d.w)) * (1.0f / 64.0f);
            const float rs = __builtin_amdgcn_rsqf(var + 64e-5f);
            const f32x4 yn = d * rs * *(const f32x4*)(p->lnx_g + l * CW + ch) + *(const f32x4*)(p->lnx_b + l * CW + ch);
            const f32x4 k = *(const f32x4*)(Kb + o), a0 = *(const f32x4*)(A0 + o), a1 = *(const f32x4*)(A1 + o), r = *(const f32x4*)(R + o), v = *(const f32x4*)(V + o);
            const f32x4 ka = *(const f32x4*)(p->k_a + l * CW + ch), rk = *(const f32x4*)(p->r_k + l * CW + ch);
            const f32x4 km = k * (2.0f + (a0 + a1 - 2.0f) * ka);
            const f32x4 tb = r * km * rk;
            const float bonus = sum16((tb.x + tb.y) + (tb.z + tb.w));
            const u32x2 gg = *(const u32x2*)(G + o);
            const float g0 = __uint_as_float(gg.x << 16), g1 = __uint_as_float(gg.x & 0xffff0000u), g2 = __uint_as_float(gg.y << 16), g3 = __uint_as_float(gg.y & 0xffff0000u);
            const f32x4 ov = yn + v * bonus;
            u32x2 w; w.x = pk2(ov.x * g0, ov.y * g1); w.y = pk2(ov.z * g2, ov.w * g3);
            *(u32x2*)(MIX + pg8::blk_off(row, 1024 + ch, D)) = w;
        }
    }
}

constexpr int NPHASE = 26;
__global__ void __launch_bounds__(NTHR, 2) fwd(Params p) {
    extern __shared__ __attribute__((aligned(16))) unsigned char lds_raw[];
    Frame F;
    F.lds = (LAS unsigned char*)lds_raw;
    F.tid = threadIdx.x; F.lane = F.tid & 63; F.wave = __builtin_amdgcn_readfirstlane(F.tid >> 6);
    F.G = gridDim.x; F.bid = blockIdx.x;
    unsigned char* const ws = p.ws;
    if (F.tid < 256) ((LAS unsigned*)(F.lds + LDS_MISC))[F.tid] = 0u;
    __syncthreads();
#if ONE_LAUNCH
    XcdBarrier bar = xcd_barrier_post((unsigned*)(ws + WS_CTL) + CW_BAR, (volatile LAS unsigned*)(F.lds + LDS_MISC));
#define SEAM(k) do { if (IN((k) + 1)) xcd_barrier(bar); } while (0)
#else
#define SEAM(k) do { } while (0)
#endif
    const int lo = p.ph_lo, hi = p.ph_hi;
#ifndef PH_MASK
#define PH_MASK 0x3fff
#endif
#define EN(i) ((PH_MASK >> (i)) & 1)
#define IN(k) (lo <= (k) && (k) < hi)
#define INL(j) (EN(1 + (j)) && IN(pb + (j)))
#ifndef REP_MASK
#define REP_MASK 0
#endif
#define NREP(j) (1 + ((REP_MASK >> (j)) & 1))
    const bf16_t* H = (const bf16_t*)(ws + WS_H);
    bf16_t* X = (bf16_t*)(ws + WS_X);

    if (EN(0) && IN(0)) for (int rep = 0; rep < NREP(15); ++rep) { p0_prologue(fresh(F), get_params()); SEAM(0); }

    for (int l = 0; l < 2; ++l) {
        const int pb = 1 + 12 * l;
        const float* modf = (const float*)(ws + WS_MODF) + (size_t)l * 5 * NMOD;
        if (INL(0)) for (int rep = 0; rep < NREP(0); ++rep) { if (l == 0) norm_phase<true>(fresh(F), get_params(), l, 0, get_params()->x_prompt, get_params()->x_sample); else norm_phase<false>(fresh(F), get_params(), l, 0, X, X + (size_t)MC * D); SEAM(pb + 0); }
        if (INL(1)) for (int rep = 0; rep < NREP(1); ++rep) {
            pg8::Gemm g{H, (const bf16_t*)(ws + WS_WFFI) + (size_t)(l * 2 + 0) * NFF * D, M, NFF, D}; pg8::SplitOrder<false> S; S.init(M, NFF, F.G, F.bid);
            pg8::EpiSwiGLU<4> E{(bf16_t*)(ws + WS_Z), DFF};
            pg8::gemm_phase<pg8::EpiSwiGLU<4>, pg8::SplitOrder<false>, GEMM_ALIGN, GEMM_SP2>(F.lds, g, S, E);
            pg8::SplitOrder<true> S2; S2.init(M, NFF, F.G, F.bid);
            pg8::EpiSwiGLU<2> E2{(bf16_t*)(ws + WS_Z), DFF};
            pg8::gemm_phase<pg8::EpiSwiGLU<2>, pg8::SplitOrder<true>, GEMM_ALIGN, GEMM_SP2, 2>(F.lds, g, S2, E2);
            SEAM(pb + 1);
        }
        if (INL(2)) {
            pg8::Gemm g{(const bf16_t*)(ws + WS_Z), (const bf16_t*)(ws + WS_WFFO) + (size_t)(l * 2 + 0) * D * DFF, M, D, DFF}; pg8::StaticOrder S; S.init(M / 192 * 256, D, F.G, F.bid);
            if (l == 0) { pg8::EpiResid<3, true> E{get_params()->x_prompt, get_params()->x_sample, X, modf, 2, 0.5f};
                pg8::gemm_phase<pg8::EpiResid<3, true>, pg8::StaticOrder, GEMM_ALIGN, GEMM_SP2, 3>(F.lds, g, S, E); }
            else { pg8::EpiResid<3, false> E{X, X + (size_t)MC * D, X, modf, 2, 0.5f};
                pg8::gemm_phase<pg8::EpiResid<3, false>, pg8::StaticOrder, GEMM_ALIGN, GEMM_SP2, 3>(F.lds, g, S, E); }
            SEAM(pb + 2);
        }
        if (INL(3)) for (int rep = 0; rep < NREP(3); ++rep) { norm_phase<false>(fresh(F), get_params(), l, 1, X, X + (size_t)MC * D); SEAM(pb + 3); }
        if (INL(4)) for (int rep = 0; rep < NREP(4); ++rep) {
            pg8::Gemm g{H, (const bf16_t*)(ws + WS_WIN) + (size_t)l * NINP * D, M, NINP, D}; pg8::SplitOrder<false> S; S.init(M, NINP, F.G, F.bid);
            pg8::EpiBf16<4> E{(bf16_t*)(ws + WS_Z), NINP};
            pg8::gemm_phase<pg8::EpiBf16<4>, pg8::SplitOrder<false>, GEMM_ALIGN, GEMM_SP2>(F.lds, g, S, E);
            pg8::SplitOrder<true> S2; S2.init(M, NINP, F.G, F.bid);
            pg8::EpiBf16<2> E2{(bf16_t*)(ws + WS_Z), NINP};
            pg8::gemm_phase<pg8::EpiBf16<2>, pg8::SplitOrder<true>, GEMM_ALIGN, GEMM_SP2, 2>(F.lds, g, S2, E2);
            SEAM(pb + 4);
        }
        if (INL(5)) for (int rep = 0; rep < NREP(5); ++rep) { mixprep_phase(fresh(F), get_params(), l); SEAM(pb + 5); }
#if defined(DBG_SPLIT)
        if (INL(6)) { for (int r2 = 0; r2 < DBG_SPLIT; ++r2) { seqmix_phase(fresh(F), get_params(), l, r2, 1 | 4); xcd_barrier(bar); }
                      for (int r3 = 0; r3 < DBG_SPLITQ; ++r3) { seqmix_phase(fresh(F), get_params(), l, r3, 2); SEAM(pb + 6); } }
#else
        if (INL(6)) for (int rep = 0; rep < NREP(6); ++rep) { seqmix_phase(fresh(F), get_params(), l, rep); SEAM(pb + 6); }
#endif
        if (INL(7)) for (int rep = 0; rep < NREP(7); ++rep) { post_phase(fresh(F), get_params(), l); SEAM(pb + 7); }
        if (INL(8)) {
            pg8::Gemm g{H, (const bf16_t*)(ws + WS_WOUT) + (size_t)l * D * D, M, D, D}; pg8::StaticOrder S; S.init(M / 192 * 256, D, F.G, F.bid);
            pg8::EpiResid<3, false> E{X, X + (size_t)MC * D, X, modf, 5, 1.0f};
            pg8::gemm_phase<pg8::EpiResid<3, false>, pg8::StaticOrder, GEMM_ALIGN, GEMM_SP2, 3>(F.lds, g, S, E);
            SEAM(pb + 8);
        }
        if (INL(9)) for (int rep = 0; rep < NREP(9); ++rep) { norm_phase<false>(fresh(F), get_params(), l, 2, X, X + (size_t)MC * D); SEAM(pb + 9); }
        if (INL(10)) {
            pg8::Gemm g{H, (const bf16_t*)(ws + WS_WFFI) + (size_t)(l * 2 + 1) * NFF * D, M, NFF, D}; pg8::SplitOrder<false> S; S.init(M, NFF, F.G, F.bid);
            pg8::EpiSwiGLU<4> E{(bf16_t*)(ws + WS_Z), DFF};
            pg8::gemm_phase<pg8::EpiSwiGLU<4>, pg8::SplitOrder<false>, GEMM_ALIGN, GEMM_SP2>(F.lds, g, S, E);
            pg8::SplitOrder<true> S2; S2.init(M, NFF, F.G, F.bid);
            pg8::EpiSwiGLU<2> E2{(bf16_t*)(ws + WS_Z), DFF};
            pg8::gemm_phase<pg8::EpiSwiGLU<2>, pg8::SplitOrder<true>, GEMM_ALIGN, GEMM_SP2, 2>(F.lds, g, S2, E2);
            SEAM(pb + 10);
        }
        if (INL(11)) {
            pg8::Gemm g{(const bf16_t*)(ws + WS_Z), (const bf16_t*)(ws + WS_WFFO) + (size_t)(l * 2 + 1) * D * DFF, M, D, DFF}; pg8::StaticOrder S; S.init(M / 192 * 256, D, F.G, F.bid);
            pg8::EpiResid<3, false> E{X, X + (size_t)MC * D, X, modf, 8, 0.5f};
            pg8::gemm_phase<pg8::EpiResid<3, false>, pg8::StaticOrder, GEMM_ALIGN, GEMM_SP2, 3>(F.lds, g, S, E);
            SEAM(pb + 11);
        }
    }
    if (EN(13) && IN(25)) final_phase(fresh(F), get_params());
#undef IN
#undef INL
#undef NREP
#undef EN
#undef SEAM
}

extern "C" void kernel_launch(void* const* d_in, const int* in_sizes, int n_in, void* d_out, int out_size, void* d_ws, size_t ws_size, hipStream_t stream) {
    static int grid = 0;
    if (grid == 0) {
        if (n_in != 28 || ws_size < WS_END) { fprintf(stderr, "kernel_launch: expected 28 inputs and >= %zu bytes of workspace (got %d, %zu)\n", (size_t)WS_END, n_in, ws_size); grid = -1; return; }
        int dev = 0, cus = 0, per_cu = 0;
        if (hipGetDevice(&dev) != hipSuccess || hipDeviceGetAttribute(&cus, hipDeviceAttributeMultiprocessorCount, dev) != hipSuccess) { grid = -1; return; }
        if (hipFuncSetAttribute((const void*)fwd, hipFuncAttributeMaxDynamicSharedMemorySize, LDS_BYTES) != hipSuccess) { fprintf(stderr, "kernel_launch: hipFuncSetAttribute failed\n"); grid = -1; return; }
        if (hipOccupancyMaxActiveBlocksPerMultiprocessor(&per_cu, (const void*)fwd, NTHR, LDS_BYTES) != hipSuccess || per_cu < 1)
            fprintf(stderr, "kernel_launch: occupancy query reports %d workgroups per CU\n", per_cu);
        (void)hipGetLastError();
        grid = cus;
    }
    if (grid < 0) return;
    (void)hipMemsetAsync((char*)d_ws + WS_CTL, 0, CTL_BYTES, stream);
    Params p{};
    const float** pin = (const float**)&p;
    for (int i = 0; i < 28; ++i) pin[i] = (const float*)d_in[i];
    p.out = (float*)d_out; p.ws = (unsigned char*)d_ws;
#if ONE_LAUNCH
    p.ph_lo = 0; p.ph_hi = NPHASE;
    hipLaunchKernelGGL(fwd, dim3(grid), dim3(NTHR), LDS_BYTES, stream, p);
#else
    for (int k = 0; k < NPHASE; ++k) { p.ph_lo = k; p.ph_hi = k + 1; hipLaunchKernelGGL(fwd, dim3(grid), dim3(NTHR), LDS_BYTES, stream, p); }
#endif
    (void)in_sizes; (void)out_size;
}
```

```cpp
#include <hip/hip_runtime.h>
#include <cstdio>
#include <cstdint>

#ifndef SCAN_CHUNKED
#define SCAN_CHUNKED 1
#endif
#ifndef LATPIPE
#define LATPIPE true
#endif
#ifndef DBG_VMW
#define DBG_VMW 21
#endif
#ifndef DBG_AFTER_WAIT
#define DBG_AFTER_WAIT
#endif
#ifndef DBG_DUP_Q
#define DBG_DUP_Q 1
#endif
#ifndef DBG_DUP_SEL
#define DBG_DUP_SEL 15
#endif
#ifndef LAT_SOLO
#define LAT_SOLO 0
#endif
#ifndef FNET_IN_POST
#define FNET_IN_POST 0
#endif
#ifndef GEMM_ALIGN
#define GEMM_ALIGN true
#endif
#ifndef GEMM_SP2
#define GEMM_SP2 true
#endif
#ifndef LAT_PRIO
#define LAT_PRIO 3
#endif
#ifndef DBG_P6A
#define DBG_P6A 1
#endif
#ifndef DBG_P6B
#define DBG_P6B 1
#endif
#ifndef DBG_P6R
#define DBG_P6R 1
#endif
#ifndef DBG_P6L
#define DBG_P6L 1
#endif
#ifndef ONE_LAUNCH
#define ONE_LAUNCH 1
#endif

namespace pg8 {
#define PG8_LAS __attribute__((address_space(3)))
typedef unsigned short bf16_t;
typedef short bf16x8 __attribute__((ext_vector_type(8)));
typedef float f32x4 __attribute__((ext_vector_type(4)));
typedef unsigned u32x4 __attribute__((ext_vector_type(4)));
constexpr int BM = 256, BK = 64, HALF = 128, HTB = HALF * BK * 2  , STAGE_BYTES = 8 * HTB, NXCD = 8, WGM = 8;

__host__ __device__ __forceinline__ int lds_byte(int r, int c) { const int st = (r >> 4) * 2 + (c >> 5), rr = r & 15, cc = c & 31, ob = rr * 64 + cc * 2; return st * 1024 + (ob ^ (((ob >> 9) & 1) << 5)); }
__host__ __device__ __forceinline__ void stage_rc(int b, int& R, int& C) { const int st = b / 1024, sb = b % 1024, swz = sb ^ (((sb >> 9) & 1) << 5); R = (st >> 1) * 16 + swz / 64; C = (st & 1) * 32 + (swz % 64) / 2; }
__host__ __device__ __forceinline__ int perm32(int rho) { const int n = rho >> 4, i = rho & 15; return 8 * (i >> 2) + 4 * n + (i & 3); }

__host__ __device__ __forceinline__ size_t blk_off(int row, int k, int K) { const int ob = (row & 15) * 64 + (k & 31) * 2; return ((size_t)(row >> 4) * (K >> 5) + (k >> 5)) * 512 + ((ob ^ (((ob >> 9) & 1) << 5)) >> 1); }
struct Unit { int pm, pn; };
struct Gemm { const bf16_t* A; const bf16_t* Bt; int M, N, K; };

struct StaticOrder {
    int nM, nN, nwg, G, c;
    __host__ __device__ void init(int M, int N, int G_, int c_) { nM = M / BM; nN = N / BM; nwg = nM * nN; G = G_; c = c_; }
    __host__ __device__ bool next(int i, Unit& u) const {
        const long L = (long)i * G + c; if (L >= nwg) return false;
        int wgid = (int)L; { const int q = nwg / NXCD, r = nwg % NXCD, xcd = wgid % NXCD, off = wgid / NXCD; wgid = (xcd < r ? xcd * (q + 1) : r * (q + 1) + (xcd - r) * q) + off; }
        const int nig = WGM * nN, gid = wgid / nig, fm = gid * WGM, gsz = (nM - fm) < WGM ? (nM - fm) : WGM;
        u.pm = fm + ((wgid % nig) % gsz); u.pn = (wgid % nig) / gsz; return true;
    }
    __device__ __forceinline__ void a_ready(const Unit&) const {}
    __device__ __forceinline__ void done(const Unit&) const {}
};
template <bool TAIL> struct SplitOrder {
    StaticOrder b; int nfull;
    __host__ __device__ void init(int M, int N, int G_, int c_) { b.init(M, N, G_, c_); nfull = (b.nwg / G_) * G_; }
    __host__ __device__ bool next(int i, Unit& u) const {
        if (!TAIL) { const long L = (long)i * b.G + b.c; if (L >= nfull) return false; return b.next(i, u); }
        const long h = (long)i * b.G + b.c; if (h >= 2L * (b.nwg - nfull)) return false;
        StaticOrder t = b; const int big = nfull + (int)(h >> 1); t.c = big % b.G; Unit v; t.next(big / b.G, v);
        u.pm = 2 * v.pm + (int)(h & 1); u.pn = v.pn; return true;
    }
    __device__ __forceinline__ void a_ready(const Unit&) const {}
    __device__ __forceinline__ void done(const Unit&) const {}
};

typedef unsigned u32x2v __attribute__((ext_vector_type(2)));
typedef float f32x2p __attribute__((ext_vector_type(2))); typedef __bf16 bf16x2p __attribute__((ext_vector_type(2)));
__device__ __forceinline__ unsigned cvt_pk_bf16(float lo, float hi) { const f32x2p v = {lo, hi}; const bf16x2p b = __builtin_convertvector(v, bf16x2p); return __builtin_bit_cast(unsigned, b); }
__device__ __forceinline__ float fsilu(float x) { return x * __builtin_amdgcn_rcpf(1.0f + __expf(-x)); }

struct EpiF32 {
    static constexpr bool PERM = false, AFTER_DRAIN = false;
    float* C; int ldc;
    __device__ __forceinline__ void operator()(const f32x4 (&acc)[2][2][4][2], const Unit& u, int wr, int wc, int fr, int fq) const {
        const int row0 = u.pm * BM + wr * 64 + fr, col0 = u.pn * BM + wc * 32 + 4 * fq;
#pragma unroll
        for (int ai = 0; ai < 2; ++ai)
#pragma unroll
            for (int m = 0; m < 4; ++m) { float* rowp = C + (size_t)(row0 + ai * HALF + m * 16) * ldc + col0;
#pragma unroll
                for (int bj = 0; bj < 2; ++bj)
#pragma unroll
                    for (int n = 0; n < 2; ++n) *(f32x4*)(rowp + bj * HALF + n * 16) = acc[ai][bj][m][n]; }
    }
};
template <int MF> struct EpiBf16 {
    static constexpr bool PERM = true, AFTER_DRAIN = false;
    bf16_t* O; int ldo;
    __device__ __forceinline__ void operator()(const f32x4 (&acc)[2][2][MF][2], const Unit& u, int wr, int wc, int fr, int fq) const {
        const int row0 = u.pm * (64 * MF) + wr * (16 * MF) + fr, col0 = u.pn * BM + wc * 32 + 8 * fq;
#pragma unroll
        for (int ai = 0; ai < 2; ++ai)
#pragma unroll
            for (int m = 0; m < MF; ++m) { bf16_t* rowp = O + (size_t)(row0 + ai * (32 * MF) + m * 16) * ldo + col0;
#pragma unroll
                for (int bj = 0; bj < 2; ++bj) { const f32x4 v0 = acc[ai][bj][m][0], v1 = acc[ai][bj][m][1];
                    u32x4 w; w.x = cvt_pk_bf16(v0[0], v0[1]); w.y = cvt_pk_bf16(v0[2], v0[3]); w.z = cvt_pk_bf16(v1[0], v1[1]); w.w = cvt_pk_bf16(v1[2], v1[3]);
                    *(u32x4*)(rowp + bj * HALF) = w; } }
    }
};
template <int MF> struct EpiSwiGLU {
    static constexpr bool PERM = true, AFTER_DRAIN = false;
    bf16_t* O; int ldo;
    __device__ __forceinline__ void operator()(const f32x4 (&acc)[2][2][MF][2], const Unit& u, int wr, int wc, int fr, int fq) const {
        const int row0 = u.pm * (64 * MF) + wr * (16 * MF) + fr, col0 = u.pn * HALF + wc * 32 + 8 * fq;
#pragma unroll
        for (int ai = 0; ai < 2; ++ai)
#pragma unroll
            for (int m = 0; m < MF; ++m) {
                const f32x4 g0 = acc[ai][0][m][0], g1 = acc[ai][0][m][1], u0 = acc[ai][1][m][0], u1 = acc[ai][1][m][1];
                u32x4 w;
                w.x = cvt_pk_bf16(fsilu(g0[0]) * u0[0], fsilu(g0[1]) * u0[1]); w.y = cvt_pk_bf16(fsilu(g0[2]) * u0[2], fsilu(g0[3]) * u0[3]);
                w.z = cvt_pk_bf16(fsilu(g1[0]) * u1[0], fsilu(g1[1]) * u1[1]); w.w = cvt_pk_bf16(fsilu(g1[2]) * u1[2], fsilu(g1[3]) * u1[3]);
                *(u32x4*)(O + blk_off(row0 + ai * (32 * MF) + m * 16, col0, ldo)) = w;
            }
    }
};
template <int MF, bool XF32IN> struct EpiResid {
    static constexpr bool PERM = true, AFTER_DRAIN = false;
    const void* xin_c; const void* xin_l; bf16_t* X; const float* modf; int jchunk; float coef;
    __device__ __forceinline__ void operator()(const f32x4 (&acc)[2][2][MF][2], const Unit& u, int wr, int wc, int fr, int fq) const {
        const int col0 = u.pn * BM + wc * 32 + 8 * fq;
#pragma unroll
        for (int ai = 0; ai < 2; ++ai)
#pragma unroll
            for (int m = 0; m < MF; ++m) {
                const int row = u.pm * (64 * MF) + ai * (32 * MF) + wr * (16 * MF) + m * 16 + fr;
                const int c = row < 8192 ? 0 : 1 + ((row - 8192) >> 10);
                const int row_in = row < 8192 ? row : row - 8192;
                const size_t xo_in = (size_t)row_in * 2048 + col0;
                const void* xb = row < 8192 ? xin_c : xin_l;

                const float* gp = modf + (size_t)c * 18432 + jchunk * 2048 + col0;
#pragma unroll
                for (int bj = 0; bj < 2; ++bj) {
                    f32x4 x0, x1;
                    if constexpr (XF32IN) { x0 = *(const f32x4*)((const float*)xb + xo_in + bj * HALF); x1 = *(const f32x4*)((const float*)xb + xo_in + bj * HALF + 4); }
                    else { const u32x4 w = *(const u32x4*)((const bf16_t*)xb + blk_off(row_in, col0 + bj * HALF, 2048));
                           x0 = (f32x4){__uint_as_float(w.x << 16), __uint_as_float(w.x & 0xffff0000u), __uint_as_float(w.y << 16), __uint_as_float(w.y & 0xffff0000u)};
                           x1 = (f32x4){__uint_as_float(w.z << 16), __uint_as_float(w.z & 0xffff0000u), __uint_as_float(w.w << 16), __uint_as_float(w.w & 0xffff0000u)}; }
                    const f32x4 g0 = *(const f32x4*)(gp + bj * HALF), g1 = *(const f32x4*)(gp + bj * HALF + 4);
                    const f32x4 o0 = x0 + (g0 * coef) * acc[ai][bj][m][0], o1 = x1 + (g1 * coef) * acc[ai][bj][m][1];
                    u32x4 wo; wo.x = cvt_pk_bf16(o0[0], o0[1]); wo.y = cvt_pk_bf16(o0[2], o0[3]); wo.z = cvt_pk_bf16(o1[0], o1[1]); wo.w = cvt_pk_bf16(o1[2], o1[3]);
                    *(u32x4*)(X + blk_off(row, col0 + bj * HALF, 2048)) = wo; }
            }
    }
};

template <class Epi, class Sched, bool ALIGN_EPI = false, bool SP2 = false, int MF = 4>
__device__ __forceinline__ void gemm_phase(PG8_LAS unsigned char* lds, const Gemm g, const Sched& S, const Epi& E) {
    int tid_ = threadIdx.x; asm volatile("" : "+v"(tid_));
    const int tid = tid_, wid = __builtin_amdgcn_readfirstlane(tid >> 6), lane = tid & 63, wr = wid >> 2, wc = wid & 3, fr = lane & 15, fq = lane >> 4;
    const int K = g.K, nt = K / BK;
    unsigned voffA[2], voffB[2];
#pragma unroll
    for (int i = 0; i < 2; ++i) { int R, C; stage_rc(tid * 16 + i * 8192, R, C); const int Rb = Epi::PERM ? ((R & ~31) + perm32(R & 31)) : R;
        const int Ra = (R >= 32 * MF) ? R - (128 - 32 * MF) : R;
        (void)Ra; (void)Rb;
        { const int st = wid + 8 * i, br = (st >> 1) < 2 * MF ? (st >> 1) : (st >> 1) - (8 - 2 * MF); voffA[i] = (unsigned)((br * (K >> 5) + (st & 1)) * 1024 + lane * 16); }
        { const int st = wid + 8 * i; voffB[i] = (unsigned)(((st >> 1) * (K >> 5) + (st & 1)) * 1024 + lane * 16); } }
    const size_t kstepA = 2048, kstepB = 2048;
    const size_t hstepB = (size_t)HALF * K * 2, tstepB = 2 * hstepB;
    const size_t hstepA = (size_t)(32 * MF) * K * 2, tstepA = 2 * hstepA;
    const unsigned ldsw = (unsigned)wid * 1024u;
    const int aoff = lds_byte(wr * (16 * MF) + fr, fq * 8), boff = lds_byte(wc * 32 + fr, fq * 8);
#define PG8_SA(b, h) (((b) * 2 + (h)) * HTB)
#define PG8_SB(b, h) ((4 + (b) * 2 + (h)) * HTB)
#define PG8_STAGE(bufoff, gbase, voff) do { _Pragma("unroll") for (int _i = 0; _i < 2; ++_i) \
        __builtin_amdgcn_global_load_lds((const unsigned*)((const char*)(gbase) + (voff)[_i]), (PG8_LAS unsigned*)(lds + (bufoff) + ldsw + _i * 8192), 16, 0, 0); } while (0)
#define PG8_LDA(dst, b, h) do { _Pragma("unroll") for (int m = 0; m < MF; ++m) _Pragma("unroll") for (int k = 0; k < 2; ++k) dst[m][k] = *(const PG8_LAS bf16x8*)(lds + PG8_SA(b, h) + aoff + m * 2048 + k * 1024); } while (0)
#define PG8_LDB(dst, b, h) do { _Pragma("unroll") for (int n = 0; n < 2; ++n) _Pragma("unroll") for (int k = 0; k < 2; ++k) dst[n][k] = *(const PG8_LAS bf16x8*)(lds + PG8_SB(b, h) + boff + n * 2048 + k * 1024); } while (0)
#define PG8_MMA(ai, bj, At, Bt) do { __builtin_amdgcn_s_setprio(1); _Pragma("unroll") for (int m = 0; m < MF; ++m) _Pragma("unroll") for (int n = 0; n < 2; ++n) _Pragma("unroll") for (int k = 0; k < 2; ++k) \
        acc[ai][bj][m][n] = __builtin_amdgcn_mfma_f32_16x16x32_bf16(Bt[n][k], At[m][k], acc[ai][bj][m][n], 0, 0, 0); __builtin_amdgcn_s_setprio(0); } while (0)
#define PG8_WAIT_V(n) asm volatile("s_waitcnt vmcnt(" #n ")" ::: "memory")
#define PG8_WAIT_L(n) asm volatile("s_waitcnt lgkmcnt(" #n ")" ::: "memory")
#define PG8_BAR __builtin_amdgcn_s_barrier()
#define PG8_SCHED __builtin_amdgcn_sched_barrier(0)
    Unit cur, nxt; int ui = 0;
    if (!S.next(0, cur)) return;
    f32x4 acc[2][2][MF][2];
#pragma unroll
    for (int a = 0; a < 2; ++a)
#pragma unroll
        for (int b = 0; b < 2; ++b)
#pragma unroll
            for (int m = 0; m < MF; ++m)
#pragma unroll
                for (int n = 0; n < 2; ++n) acc[a][b][m][n] = (f32x4){0.f, 0.f, 0.f, 0.f};
    bf16x8 At[MF][2], B0[2][2], B1[2][2];
    const char* cA = (const char*)g.A + (size_t)cur.pm * tstepA; const char* cB = (const char*)g.Bt + (size_t)cur.pn * tstepB;
    S.a_ready(cur);
    if constexpr (SP2) {
        PG8_STAGE(PG8_SB(0, 0), cB, voffB); PG8_STAGE(PG8_SB(0, 1), cB + hstepB, voffB); PG8_STAGE(PG8_SA(0, 0), cA, voffA); PG8_STAGE(PG8_SA(0, 1), cA + hstepA, voffA);
        if (wr == 1) PG8_BAR;
        PG8_WAIT_V(2); PG8_BAR;
        PG8_STAGE(PG8_SB(1, 0), cB + kstepB, voffB); PG8_STAGE(PG8_SA(1, 0), cA + kstepA, voffA); PG8_STAGE(PG8_SB(1, 1), cB + hstepB + kstepB, voffB);
        PG8_WAIT_V(6); PG8_BAR;
    } else {
        PG8_STAGE(PG8_SB(0, 0), cB, voffB); PG8_STAGE(PG8_SA(0, 0), cA, voffA); PG8_STAGE(PG8_SB(0, 1), cB + hstepB, voffB); PG8_STAGE(PG8_SA(0, 1), cA + hstepA, voffA);
        if (wr == 1) PG8_BAR;
        PG8_WAIT_V(4); PG8_BAR;
        PG8_STAGE(PG8_SB(1, 0), cB + kstepB, voffB); PG8_STAGE(PG8_SA(1, 0), cA + kstepA, voffA); PG8_STAGE(PG8_SB(1, 1), cB + hstepB + kstepB, voffB);
        PG8_WAIT_V(6); PG8_BAR;
    }
    for (;;) {
        const bool has_next = S.next(ui + 1, nxt);
        const char* nA = has_next ? (const char*)g.A + (size_t)nxt.pm * tstepA : cA; const char* nB = has_next ? (const char*)g.Bt + (size_t)nxt.pn * tstepB : cB;
        for (int t = 0; t < nt; t += 2) {
            const bool last = (t == nt - 2);
            const char* a1 = cA + (size_t)(t + 1) * kstepA;
            const char* a2 = last ? nA : cA + (size_t)(t + 2) * kstepA; const char* b2 = last ? nB : cB + (size_t)(t + 2) * kstepB;
            const char* a3 = a2 + kstepA; const char* b3 = b2 + kstepB;
            if (last && has_next) S.a_ready(nxt);
            if constexpr (SP2) {
            PG8_LDB(B0, 0, 0); PG8_LDB(B1, 0, 1); PG8_SCHED; PG8_LDA(At, 0, 0); PG8_STAGE(PG8_SA(1, 1), a1 + hstepA, voffA);
            PG8_WAIT_V(8); PG8_WAIT_L(0); PG8_BAR; PG8_MMA(0, 0, At, B0); PG8_MMA(0, 1, At, B1); PG8_BAR; PG8_SCHED;
            PG8_LDA(At, 0, 1); PG8_STAGE(PG8_SB(0, 0), b2, voffB); PG8_STAGE(PG8_SB(0, 1), b2 + hstepB, voffB); PG8_STAGE(PG8_SA(0, 0), a2, voffA);
            PG8_WAIT_V(8); PG8_WAIT_L(0); PG8_BAR; PG8_MMA(1, 0, At, B0); PG8_MMA(1, 1, At, B1); PG8_BAR; PG8_SCHED;
            PG8_LDB(B0, 1, 0); PG8_LDB(B1, 1, 1); PG8_SCHED; PG8_LDA(At, 1, 0); PG8_STAGE(PG8_SA(0, 1), a2 + hstepA, voffA);
            PG8_WAIT_V(8); PG8_WAIT_L(0); PG8_BAR; PG8_MMA(0, 0, At, B0); PG8_MMA(0, 1, At, B1); PG8_BAR; PG8_SCHED;
            PG8_LDA(At, 1, 1); PG8_STAGE(PG8_SB(1, 0), b3, voffB); PG8_STAGE(PG8_SB(1, 1), b3 + hstepB, voffB); PG8_STAGE(PG8_SA(1, 0), a3, voffA);
            PG8_WAIT_V(8); PG8_WAIT_L(0); PG8_BAR; PG8_MMA(1, 0, At, B0); PG8_MMA(1, 1, At, B1); PG8_BAR; PG8_SCHED;
            } else {
            PG8_LDB(B0, 0, 0); PG8_SCHED; PG8_LDA(At, 0, 0); PG8_STAGE(PG8_SA(1, 1), a1 + hstepA, voffA);
            PG8_WAIT_L(8); PG8_BAR; PG8_WAIT_L(0); PG8_MMA(0, 0, At, B0); PG8_BAR; PG8_SCHED;
            PG8_LDB(B1, 0, 1); PG8_STAGE(PG8_SB(0, 0), b2, voffB);
            PG8_BAR; PG8_WAIT_L(0); PG8_MMA(0, 1, At, B1); PG8_BAR;
            PG8_LDA(At, 0, 1); PG8_STAGE(PG8_SA(0, 0), a2, voffA);
            PG8_BAR; PG8_WAIT_L(0); PG8_MMA(1, 0, At, B0); PG8_BAR; PG8_SCHED;
            PG8_STAGE(PG8_SB(0, 1), b2 + hstepB, voffB);
            PG8_WAIT_V(6); PG8_BAR; PG8_MMA(1, 1, At, B1); PG8_BAR;
            PG8_LDB(B0, 1, 0); PG8_SCHED; PG8_LDA(At, 1, 0); PG8_STAGE(PG8_SA(0, 1), a2 + hstepA, voffA);
            PG8_WAIT_L(8); PG8_BAR; PG8_WAIT_L(0); PG8_MMA(0, 0, At, B0); PG8_BAR; PG8_SCHED;
            PG8_LDB(B1, 1, 1); PG8_STAGE(PG8_SB(1, 0), b3, voffB);
            PG8_BAR; PG8_WAIT_L(0); PG8_MMA(0, 1, At, B1); PG8_BAR;
            PG8_LDA(At, 1, 1); PG8_STAGE(PG8_SA(1, 0), a3, voffA);
            PG8_BAR; PG8_WAIT_L(0); PG8_MMA(1, 0, At, B0); PG8_BAR; PG8_SCHED;
            PG8_STAGE(PG8_SB(1, 1), b3 + hstepB, voffB);
            PG8_WAIT_V(6); PG8_BAR; PG8_MMA(1, 1, At, B1); PG8_BAR;
            }
        }
        if constexpr (ALIGN_EPI) { if (wr == 0) PG8_BAR; }
        if constexpr (!Epi::AFTER_DRAIN) { E(acc, cur, wr, wc, fr, fq); S.done(cur); }
        if (!has_next) break;
#pragma unroll
        for (int a = 0; a < 2; ++a)
#pragma unroll
            for (int b = 0; b < 2; ++b)
#pragma unroll
                for (int m = 0; m < MF; ++m)
#pragma unroll
                    for (int n = 0; n < 2; ++n) acc[a][b][m][n] = (f32x4){0.f, 0.f, 0.f, 0.f};
        cur = nxt; cA = nA; cB = nB; ++ui;
        if constexpr (ALIGN_EPI) { if (wr == 1) PG8_BAR; }
    }
    PG8_WAIT_V(0);
    if constexpr (!ALIGN_EPI) { if (wr == 0) PG8_BAR; }
    PG8_BAR;
    if constexpr (Epi::AFTER_DRAIN) { E.fused(acc, cur, wr, wc, fr, fq, lds, wid, lane); S.done(cur); }
#undef PG8_SA
#undef PG8_SB
#undef PG8_STAGE
#undef PG8_LDA
#undef PG8_LDB
#undef PG8_MMA
#undef PG8_WAIT_V
#undef PG8_WAIT_L
#undef PG8_BAR
#undef PG8_SCHED
}
}

#define XB_TMO      128
#define XB_XCNT(j)  (256  + 64 * (j))
#define XB_XSUB(j)  (1280 + 64 * (j))
#define XB_XGEN(j)  (2304 + 64 * (j))
#define XB_TOP      3328
#define XB_TOPGEN   3392
#define XCD_BAR_WORDS 3456
#define XB_SPIN_CAP (1u << 18)
#define LAS __attribute__((address_space(3)))

__device__ __forceinline__ unsigned xb_ld(unsigned* p)              { return __hip_atomic_load(p, __ATOMIC_RELAXED, __HIP_MEMORY_SCOPE_AGENT); }
__device__ __forceinline__ unsigned xb_add(unsigned* p, unsigned v) { return __hip_atomic_fetch_add(p, v, __ATOMIC_RELAXED, __HIP_MEMORY_SCOPE_AGENT); }
__device__ __forceinline__ unsigned xb_xcc_id() { return (unsigned)__builtin_amdgcn_s_getreg((3 << 11) | 20) & 0xFu; }
#define XB_SPIN(cond, bar) do { unsigned _sp = 0; while (cond) { __builtin_amdgcn_s_sleep(1); \
    if ((++_sp & 255u) == 0u) { if (xb_ld(&(bar)[XB_TMO])) break; if (_sp > XB_SPIN_CAP) { atomicAdd(&(bar)[XB_TMO], 1u); break; } } } } while (0)

struct XcdBarrier {
    unsigned* bar; unsigned x;
    volatile LAS unsigned* st;
};

__device__ __forceinline__ XcdBarrier xcd_barrier_post(unsigned* bar, volatile LAS unsigned* st) {
    XcdBarrier b; b.bar = bar; b.x = xb_xcc_id(); b.st = st;
    if (threadIdx.x == 0) (void)xb_add(&bar[XB_XCNT(b.x)], 1u);
    return b;
}
__device__ __forceinline__ void xcd_barrier_complete(unsigned* bar, unsigned x, unsigned& nloc, unsigned& nx) {
    const unsigned G = gridDim.x * gridDim.y * gridDim.z;
    unsigned sum, cnt, mine, sp = 0u;
    for (;;) {
        sum = 0u; cnt = 0u; mine = 0u;
#pragma unroll
        for (unsigned j = 0; j < 16; ++j) { const unsigned c = xb_ld(&bar[XB_XCNT(j)]); sum += c; cnt += (c > 0u) ? 1u : 0u; mine = (j == x) ? c : mine; }
        if (sum == G) break;
        __builtin_amdgcn_s_sleep(1);
        if ((++sp & 255u) == 0u) { if (xb_ld(&bar[XB_TMO])) break; if (sp > XB_SPIN_CAP) { atomicAdd(&bar[XB_TMO], 1u); break; } }
    }
    nloc = mine > 0u ? mine : 1u; nx = cnt > 0u ? cnt : 1u;
}

__device__ __forceinline__ void xcd_barrier(const XcdBarrier& b) {
    asm volatile("s_waitcnt vmcnt(0)" ::: "memory");
    __syncthreads();
    if (threadIdx.x == 0) {
        unsigned* bar = b.bar;
        __builtin_amdgcn_s_waitcnt(0);
        unsigned nloc = b.st[0], nx = b.st[1];
        if (nloc == 0u) { xcd_barrier_complete(bar, b.x, nloc, nx); b.st[0] = nloc; b.st[1] = nx; }
        const unsigned old = xb_add(&bar[XB_XSUB(b.x)], 1u);
        const unsigned gen = old / nloc;
        if (old + 1u == (gen + 1u) * nloc) {
            __builtin_amdgcn_fence(__ATOMIC_RELEASE, "agent");
            asm volatile("s_waitcnt vmcnt(0)" ::: "memory");
            const unsigned og = xb_add(&bar[XB_TOP], 1u);
            const unsigned tg = og / nx;
            if (og + 1u == (tg + 1u) * nx) xb_add(&bar[XB_TOPGEN], 1u);
            else XB_SPIN(xb_ld(&bar[XB_TOPGEN]) == tg, bar);
            __builtin_amdgcn_fence(__ATOMIC_ACQUIRE, "agent");
            xb_add(&bar[XB_XGEN(b.x)], 1u);
            asm volatile("s_waitcnt vmcnt(0)" ::: "memory");
        } else {
            XB_SPIN(xb_ld(&bar[XB_XGEN(b.x)]) == gen, bar);
            __builtin_amdgcn_fence(__ATOMIC_ACQUIRE, "agent");
            asm volatile("s_waitcnt vmcnt(0)" ::: "memory");
        }
    }
    __syncthreads();
}


#define LAS __attribute__((address_space(3)))
typedef unsigned short bf16_t;
typedef short bf16x8 __attribute__((ext_vector_type(8)));
typedef float f32x4 __attribute__((ext_vector_type(4)));
typedef float f32x2 __attribute__((ext_vector_type(2)));
typedef unsigned u32x4 __attribute__((ext_vector_type(4)));
typedef unsigned u32x2 __attribute__((ext_vector_type(2)));

constexpr int D = 2048, MC = 8192, ML = 4096, M = MC + ML, DFF = 5632, NFF = 2 * DFF, NIN = 5024, NINP = 5120, CW = 1024;
constexpr int ZC0 = 1536, CIN = 3488, NMOD = 18432;
constexpr int NWAVES = 8, NTHR = 512;
constexpr int LDS_BYTES = 159744;
constexpr int LDS_MISC = 155136;

constexpr size_t al256(size_t x) { return (x + 255) & ~(size_t)255; }
constexpr size_t WS_CTL = 0;
constexpr size_t CTL_BYTES = 32768;
constexpr size_t WS_MODP = WS_CTL + CTL_BYTES;
constexpr size_t WS_MODF = al256(WS_MODP + (size_t)2 * 4 * 5 * NMOD * 4);
constexpr size_t WS_W2T = al256(WS_MODF + (size_t)2 * 5 * NMOD * 4);
constexpr size_t WS_A2T = WS_W2T + (size_t)2 * 2 * 1024 * 64 * 2;
constexpr size_t WS_G2T = WS_A2T + (size_t)2 * 2 * 1024 * 64 * 2;
constexpr size_t WS_SGUW = al256(WS_G2T + (size_t)2 * 1024 * 160 * 2);
constexpr size_t WS_CS128 = WS_SGUW + (size_t)2 * 4 * 128 * 128 * 2;
constexpr size_t WS_DFTL = WS_CS128 + (size_t)256 * 128 * 2;
constexpr size_t WS_DFTC = WS_DFTL + (size_t)1024 * 2048 * 2;
constexpr size_t WS_WFFI = al256(WS_DFTC + (size_t)256 * 512 * 2);
constexpr size_t WS_WFFO = WS_WFFI + (size_t)4 * NFF * D * 2;
constexpr size_t WS_WIN = WS_WFFO + (size_t)4 * D * DFF * 2;
constexpr size_t WS_WOUT = WS_WIN + (size_t)2 * NINP * D * 2;
constexpr size_t WS_X = WS_WOUT + (size_t)2 * D * D * 2;
constexpr size_t WS_H = WS_X + (size_t)M * D * 4;
constexpr size_t WS_Z = WS_H + (size_t)M * D * 2;
constexpr size_t WS_SC = WS_Z + (size_t)M * NINP * 4;
constexpr size_t SC_ARR = (size_t)M * CW * 4;
constexpr size_t WS_G = WS_SC + 7 * SC_ARR;
constexpr size_t WS_INVN = WS_G + (size_t)M * CW * 2;
constexpr size_t WS_U = WS_INVN + (size_t)M * 16 * 4;
constexpr size_t WS_VNT = WS_U + (size_t)M * 512 * 2;
constexpr size_t WS_TTB = WS_VNT + (size_t)M * 512 * 2;
constexpr size_t WS_TW = WS_TTB + (size_t)M * 512 * 2 * 2;
constexpr size_t WS_AD = WS_TW + (size_t)M * 128 * 2;
constexpr size_t WS_GS = WS_AD + (size_t)M * 128 * 2;
constexpr size_t WS_END = WS_GS + (size_t)M * 160 * 2;
static_assert(WS_END <= (size_t)1207959552, "workspace must fit 4 x the largest input");
static_assert((size_t)M * DFF * 2 <= (size_t)M * NINP * 4 && 2 * SC_ARR <= (size_t)M * NINP * 4, "overlays fit in Z");

constexpr int CW_BAR = 0;
constexpr int CW_JOB = 4096;
constexpr int CW_SPLITK = 6144;

__host__ __device__ __forceinline__ size_t frag_addr(int row, int k, int K2) { return ((size_t)(row >> 4) * (K2 >> 5) + (k >> 5)) * 512 + ((row & 15) + 16 * ((k & 31) >> 3)) * 8 + (k & 7); }
struct Params {
    const float *x_prompt, *x_sample, *state_wkv, *c, *c_ctx, *norm_g, *w_mod, *b_mod, *ffn_w_in, *ffn_w_out, *w_in, *w_out, *sgu_ln_g, *sgu_ln_b, *sgu_w, *sgu_b,
                *shift_mu, *decay_w0, *decay_w2, *iclr_a0, *iclr_a2, *k_k, *k_a, *r_k, *gate_w2, *lnx_g, *lnx_b, *final_g;
    float* out; unsigned char* ws; int ph_lo, ph_hi;
};

typedef __bf16 bf16x2_t __attribute__((ext_vector_type(2)));
__device__ __forceinline__ unsigned pk2(float lo, float hi) { const f32x2 v = {lo, hi}; const bf16x2_t b = __builtin_convertvector(v, bf16x2_t); return __builtin_bit_cast(unsigned, b); }
__device__ __forceinline__ float frcp(float x) { return __builtin_amdgcn_rcpf(x); }
__device__ __forceinline__ float fsigmoid(float x) { return frcp(1.0f + __expf(-x)); }
__device__ __forceinline__ float fsilu(float x) { return x * fsigmoid(x); }
__device__ __forceinline__ float ftanh(float x) { return 1.0f - 2.0f * frcp(1.0f + __expf(2.0f * x)); }
__device__ __forceinline__ float fgelu(float x) { return 0.5f * x * (1.0f + ftanh(0.7978845608f * (x + 0.044715f * x * x * x))); }
__device__ __forceinline__ float bf2f(unsigned short b) { return __uint_as_float(((unsigned)b) << 16); }
__device__ __forceinline__ float wave_sum(float v) {
#pragma unroll
    for (int o = 1; o < 64; o <<= 1) v += __shfl_xor(v, o);
    return v;
}
__device__ __forceinline__ float sum16(float v) {
#pragma unroll
    for (int o = 1; o < 16; o <<= 1) v += __shfl_xor(v, o);
    return v;
}
__device__ __forceinline__ bf16x8 ld8f_bf16(const float* p) {
    const f32x4 a = *(const f32x4*)p, b = *(const f32x4*)(p + 4);
    u32x4 w; w.x = pk2(a.x, a.y); w.y = pk2(a.z, a.w); w.z = pk2(b.x, b.y); w.w = pk2(b.z, b.w);
    return __builtin_bit_cast(bf16x8, w);
}
__device__ __forceinline__ f32x4 ld4bf(const bf16_t* p) {
    const u32x2 w = *(const u32x2*)p; f32x4 r; r.x = __uint_as_float(w.x << 16); r.y = __uint_as_float(w.x & 0xffff0000u); r.z = __uint_as_float(w.y << 16); r.w = __uint_as_float(w.y & 0xffff0000u); return r;
}
__device__ __forceinline__ int cond_of_row(int row) { return row < MC ? 0 : 1 + ((row - MC) >> 10); }
#define MFMA16(a, b, c) __builtin_amdgcn_mfma_f32_16x16x32_bf16((a), (b), (c), 0, 0, 0)

typedef const __attribute__((address_space(4))) Params* CParams;
__device__ __forceinline__ CParams get_params() { CParams q = (CParams)__builtin_amdgcn_kernarg_segment_ptr(); asm volatile("" : "+s"(q)); return q; }

struct Frame {
    LAS unsigned char* lds; int tid, lane, wave, G, bid;
};
__device__ __forceinline__ Frame fresh(const Frame& F) { Frame R = F; asm volatile("" : "+v"(R.tid)); R.lane = R.tid & 63; return R; }

struct P0Item { const float* W; bf16_t* WT; int ldw, k0, n0, ldk, drow0, mode; };
__device__ __forceinline__ void p0_item_load(const P0Item& I, float (&v)[32], int lane) {
#pragma unroll
    for (int i = 0; i < 32; ++i) v[i] = I.W[(size_t)(I.k0 + 2 * i + (lane >> 5)) * I.ldw + I.n0 + (lane & 31)];
}
__device__ __forceinline__ void p0_item_park(const float (&v)[32], LAS float* scr, int lane) {
#pragma unroll
    for (int i = 0; i < 32; ++i) scr[(2 * i + (lane >> 5)) * 33 + (lane & 31)] = v[i];
}
__device__ __forceinline__ void p0_item_store(const P0Item& I, const LAS float* scr, int lane) {
    const int c = lane & 7;
#pragma unroll
    for (int j = 0; j < 4; ++j) { const int n = (lane >> 3) + 8 * j; const LAS float* s = scr + (8 * c) * 33 + n;
        u32x4 o; o.x = pk2(s[0 * 33], s[1 * 33]); o.y = pk2(s[2 * 33], s[3 * 33]); o.z = pk2(s[4 * 33], s[5 * 33]); o.w = pk2(s[6 * 33], s[7 * 33]);
        size_t off = (size_t)(I.drow0 + n) * I.ldk + I.k0 + 8 * c;
        if (I.mode) { const int rho = I.mode == 2 ? 16 * ((n >> 2) & 1) + 4 * (n >> 3) + (n & 3) : n;
            const int ob = (rho & 15) * 64 + (c & 3) * 16;
            off = ((size_t)((I.drow0 >> 4) + (rho >> 4)) * (I.ldk >> 5) + (I.k0 >> 5) + (c >> 2)) * 512 + ((ob ^ (((ob >> 9) & 1) << 5)) >> 1); }
        *(u32x4*)(I.WT + off) = o; }
}
__device__ __forceinline__ void p0_transpose_item(const float* W, int ldw, int k0, int n0, bf16_t* WT, int ldk, int drow0, LAS float* scr, int lane) {
#pragma unroll 8
    for (int i = 0; i < 32; ++i) { const int kk = 2 * i + (lane >> 5); scr[kk * 33 + (lane & 31)] = W[(size_t)(k0 + kk) * ldw + n0 + (lane & 31)]; }
    asm volatile("s_waitcnt lgkmcnt(0)" ::: "memory");
    const int c = lane & 7;
#pragma unroll
    for (int j = 0; j < 4; ++j) { const int n = (lane >> 3) + 8 * j; const LAS float* s = scr + (8 * c) * 33 + n;
        u32x4 o; o.x = pk2(s[0 * 33], s[1 * 33]); o.y = pk2(s[2 * 33], s[3 * 33]); o.z = pk2(s[4 * 33], s[5 * 33]); o.w = pk2(s[6 * 33], s[7 * 33]);
        *(u32x4*)(WT + (size_t)(drow0 + n) * ldk + k0 + 8 * c) = o; }
    asm volatile("s_waitcnt lgkmcnt(0)" ::: "memory");
}

constexpr int P0_I_FFI = 32 * 352, P0_I_FFO = 88 * 64, P0_I_IN = 32 * 157, P0_I_OUT = 32 * 64, P0_I_LR = 32;
constexpr int P0_NL = 2 * P0_I_FFI + 2 * P0_I_FFO + P0_I_IN + P0_I_OUT + 4 * P0_I_LR;
__device__ __forceinline__ P0Item p0_layer_desc(CParams p, int l, int it) {
    unsigned char* ws = p->ws; P0Item I; int r = it;
    if (r < 2 * P0_I_FFI) { const int mi = l * 2 + r / P0_I_FFI; r %= P0_I_FFI; const int kb = r / 352, nb = r % 352, n0 = nb * 32;
        const int j = n0 < DFF ? n0 : n0 - DFF; const int drow = 256 * (j >> 7) + (n0 < DFF ? 0 : 128) + (j & 127);
        I.W = p->ffn_w_in + (size_t)mi * D * NFF; I.ldw = NFF; I.k0 = kb * 64; I.n0 = n0; I.WT = (bf16_t*)(ws + WS_WFFI) + (size_t)mi * NFF * D; I.ldk = D; I.drow0 = drow; I.mode = 2; return I; }
    r -= 2 * P0_I_FFI;
    if (r < 2 * P0_I_FFO) { const int mi = l * 2 + r / P0_I_FFO; r %= P0_I_FFO; const int kb = r / 64, nb = r % 64;
        I.W = p->ffn_w_out + (size_t)mi * DFF * D; I.ldw = D; I.k0 = kb * 64; I.n0 = nb * 32; I.WT = (bf16_t*)(ws + WS_WFFO) + (size_t)mi * D * DFF; I.ldk = DFF; I.drow0 = nb * 32; I.mode = 2; return I; }
    r -= 2 * P0_I_FFO;
    if (r < P0_I_IN) { const int kb = r / 157, nb = r % 157;
        I.W = p->w_in + (size_t)l * D * NIN; I.ldw = NIN; I.k0 = kb * 64; I.n0 = nb * 32; I.WT = (bf16_t*)(ws + WS_WIN) + (size_t)l * NINP * D; I.ldk = D; I.drow0 = nb * 32; I.mode = 2; return I; }
    r -= P0_I_IN;
    if (r < P0_I_OUT) { const int kb = r / 64, nb = r % 64;
        I.W = p->w_out + (size_t)l * D * D; I.ldw = D; I.k0 = kb * 64; I.n0 = nb * 32; I.WT = (bf16_t*)(ws + WS_WOUT) + (size_t)l * D * D; I.ldk = D; I.drow0 = nb * 32; I.mode = 2; return I; }
    r -= P0_I_OUT;
    { const int q = r / P0_I_LR, nb = r % P0_I_LR, md = l * 2 + (q & 1);
      I.W = (q < 2 ? p->decay_w2 : p->iclr_a2) + (size_t)md * 64 * CW; I.ldw = CW; I.k0 = 0; I.n0 = nb * 32;
      I.WT = (bf16_t*)(ws + (q < 2 ? WS_W2T : WS_A2T)) + (size_t)md * CW * 64; I.ldk = 64; I.drow0 = nb * 32; I.mode = 0; return I; }
}
__device__ __forceinline__ void p0_layer_item(CParams p, int l, int it, LAS float* scr, int lane) {
    unsigned char* ws = p->ws;
    int r = it;
    if (r < 2 * P0_I_FFI) { const int mi = l * 2 + r / P0_I_FFI; r %= P0_I_FFI; const int kb = r / 352, nb = r % 352, n0 = nb * 32;
        const int j = n0 < DFF ? n0 : n0 - DFF; const int drow = 256 * (j >> 7) + (n0 < DFF ? 0 : 128) + (j & 127);
        p0_transpose_item(p->ffn_w_in + (size_t)mi * D * NFF, NFF, kb * 64, n0, (bf16_t*)(ws + WS_WFFI) + (size_t)mi * NFF * D, D, drow, scr, lane); return; }
    r -= 2 * P0_I_FFI;
    if (r < 2 * P0_I_FFO) { const int mi = l * 2 + r / P0_I_FFO; r %= P0_I_FFO; const int kb = r / 64, nb = r % 64;
        p0_transpose_item(p->ffn_w_out + (size_t)mi * DFF * D, D, kb * 64, nb * 32, (bf16_t*)(ws + WS_WFFO) + (size_t)mi * D * DFF, DFF, nb * 32, scr, lane); return; }
    r -= 2 * P0_I_FFO;
    if (r < P0_I_IN) { const int kb = r / 157, nb = r % 157;
        p0_transpose_item(p->w_in + (size_t)l * D * NIN, NIN, kb * 64, nb * 32, (bf16_t*)(ws + WS_WIN) + (size_t)l * NINP * D, D, nb * 32, scr, lane); return; }
    r -= P0_I_IN;
    if (r < P0_I_OUT) { const int kb = r / 64, nb = r % 64;
        p0_transpose_item(p->w_out + (size_t)l * D * D, D, kb * 64, nb * 32, (bf16_t*)(ws + WS_WOUT) + (size_t)l * D * D, D, nb * 32, scr, lane); return; }
    r -= P0_I_OUT;
    { const int q = r / P0_I_LR, nb = r % P0_I_LR, md = l * 2 + (q & 1);
      const float* W = (q < 2 ? p->decay_w2 : p->iclr_a2) + (size_t)md * 64 * CW;
      bf16_t* WT = (bf16_t*)(ws + (q < 2 ? WS_W2T : WS_A2T)) + (size_t)md * CW * 64;
      p0_transpose_item(W, CW, 0, nb * 32, WT, 64, nb * 32, scr, lane); }
}

__device__ __forceinline__ void p0_prologue(const Frame& F, CParams p) {
    unsigned char* ws = p->ws;
    LAS float* sl = (LAS float*)F.lds;
    LAS float* red = (LAS float*)(F.lds + 40960);
    for (int i = F.tid; i < 5 * 2048; i += NTHR) { const int c = i >> 11, k = i & 2047; const float v = (c == 0) ? p->c_ctx[k] : p->c[(c - 1) * 2048 + k]; sl[i] = fsilu(v); }
    __syncthreads();
    float* modp = (float*)(ws + WS_MODP);
    for (int u = F.bid; u < 2 * 72 * 4; u += F.G) {
        const int l = u / 288, r = u % 288, cb = r >> 2, kq = r & 3;
        const int kbase = kq * 512 + F.wave * 64, col = cb * 256 + F.lane * 4;
        const float* wp = p->w_mod + ((size_t)l * 2048 + kbase) * NMOD + col;
        f32x4 acc[5];
#pragma unroll
        for (int c = 0; c < 5; ++c) acc[c] = (f32x4){0.f, 0.f, 0.f, 0.f};
#pragma unroll 8
        for (int k = 0; k < 64; ++k) {
            const f32x4 w = *(const f32x4*)(wp + (size_t)k * NMOD);
#pragma unroll
            for (int c = 0; c < 5; ++c) acc[c] += w * sl[c * 2048 + kbase + k];
        }
#pragma unroll
        for (int c = 0; c < 5; ++c) *(LAS f32x4*)(red + (F.wave * 5 + c) * 256 + F.lane * 4) = acc[c];
        __syncthreads();
        if (F.tid < 320) { const int c = F.tid >> 6, q = F.tid & 63; f32x4 s = (f32x4){0.f, 0.f, 0.f, 0.f};
#pragma unroll
            for (int w = 0; w < 8; ++w) s += *(LAS f32x4*)(red + (w * 5 + c) * 256 + q * 4);
            *(f32x4*)(modp + ((size_t)(l * 4 + kq) * 5 + c) * NMOD + cb * 256 + q * 4) = s; }
        __syncthreads();
    }
    LAS float* scrA = (LAS float*)(F.lds + F.wave * 16896); LAS float* scrB = scrA + 2112;
    const int gw = F.bid * NWAVES + F.wave, NGW = F.G * NWAVES;
    for (int it = gw; it < 2 * P0_NL; it += 2 * NGW) {
        const int itb = it + NGW; const bool hasb = itb < 2 * P0_NL;
        const P0Item IA = p0_layer_desc(p, it >= P0_NL ? 1 : 0, it >= P0_NL ? it - P0_NL : it);
        const int itc = hasb ? itb : it;
        const P0Item IB = p0_layer_desc(p, itc >= P0_NL ? 1 : 0, itc >= P0_NL ? itc - P0_NL : itc);
        float va[32], vb[32];
        p0_item_load(IA, va, F.lane); p0_item_load(IB, vb, F.lane);
        p0_item_park(va, scrA, F.lane); p0_item_park(vb, scrB, F.lane);
        asm volatile("s_waitcnt lgkmcnt(0)" ::: "memory");
        p0_item_store(IA, scrA, F.lane);
        if (hasb) p0_item_store(IB, scrB, F.lane);
        asm volatile("s_waitcnt lgkmcnt(0)" ::: "memory");
    }
    const int gt = F.bid * NTHR + F.tid, NGT = F.G * NTHR;
    { bf16_t* g2t = (bf16_t*)(ws + WS_G2T);
      for (int i = gt; i < 2 * 1024 * 160; i += NGT) { const int l = i / (1024 * 160), r = i % (1024 * 160), n = r / 160, k = r % 160;
          g2t[i] = (bf16_t)(pk2(p->gate_w2[((size_t)l * 160 + k) * 1024 + n], 0.f) & 0xffffu); } }
    { bf16_t* sw = (bf16_t*)(ws + WS_SGUW);
      for (int i = gt; i < 2 * 4 * 128 * 128; i += NGT) sw[i] = (bf16_t)(pk2(p->sgu_w[i], 0.f) & 0xffffu); }
    { bf16_t* cs = (bf16_t*)(ws + WS_CS128);
      for (int i = gt; i < 256 * 128; i += NGT) { const int m = i >> 7, d = i & 127, ph = ((m & 127) * d) & 127; const float a = (float)ph * (1.0f / 64.0f);
          cs[i] = (bf16_t)(pk2(m < 128 ? cospif(a) : sinpif(a), 0.f) & 0xffffu); } }
    { bf16_t* dl = (bf16_t*)(ws + WS_DFTL); const float sc = 0.00276213586f;
      for (int i = gt; i < 1024 * 2048; i += NGT) { const int t = i >> 11, k = i & 2047, s = k & 1023, ph = (t * s) & 1023; const float a = (float)ph * (1.0f / 512.0f);
          dl[frag_addr(t, k, 2048)] = (bf16_t)(pk2((k < 1024 ? cospif(a) : -sinpif(a)) * sc, 0.f) & 0xffffu); } }
    { bf16_t* dc = (bf16_t*)(ws + WS_DFTC); const float sc = 0.00552427173f;
      for (int i = gt; i < 256 * 512; i += NGT) { const int t = i >> 9, k = i & 511, s = k & 255, ph = (t * s) & 255; const float a = (float)ph * (1.0f / 128.0f);
          dc[frag_addr(t, k, 512)] = (bf16_t)(pk2((k < 256 ? cospif(a) : -sinpif(a)) * sc, 0.f) & 0xffffu); } }
    { unsigned* wp = (unsigned*)(ws + WS_WIN);
      for (int i = gt; i < 2 * 96 * 1024; i += NGT) { const int l = i / (96 * 1024), r = i % (96 * 1024); wp[(size_t)l * NINP * 1024 + (size_t)NIN * 1024 + r] = 0u; } }
}

template <bool XF32> __device__ __forceinline__ void norm_phase(const Frame& F, CParams p, int l, int isub, const void* xc, const void* xl) {
    LAS float* gs = (LAS float*)F.lds;
    LAS float* sh = gs + 2048;
    const float* modp = (const float*)(p->ws + WS_MODP) + (size_t)l * 4 * 5 * NMOD;
    const float* bm = p->b_mod + (size_t)l * NMOD;
    const float* ng = p->norm_g + ((size_t)l * 3 + isub) * D;
    bf16_t* H = (bf16_t*)(p->ws + WS_H);
    if (isub == 0) {
        float* modf = (float*)(p->ws + WS_MODF) + (size_t)l * 5 * NMOD;
        for (int i = F.bid * NTHR + F.tid; i < 5 * NMOD / 4; i += F.G * NTHR) { const int c = i / (NMOD / 4), j4 = i % (NMOD / 4);
            f32x4 s = *(const f32x4*)(bm + 4 * j4);
#pragma unroll
            for (int q = 0; q < 4; ++q) s += *(const f32x4*)(modp + (size_t)(q * 5 + c) * NMOD + 4 * j4);
            *(f32x4*)(modf + (size_t)c * NMOD + 4 * j4) = s; }
    }
    const int hl = F.lane & 31, hrow = F.lane >> 5;
    for (int u = F.bid; u < M / 48; u += F.G) {
        int cur = -1;
        for (int rr = 0; rr < 3; ++rr) {
            const int row = u * 48 + rr * 16 + 2 * F.wave + hrow;
            const int c0 = cond_of_row(u * 48 + rr * 16);
            if (c0 != cur) {
                __syncthreads();
                for (int i = F.tid; i < 2048; i += NTHR) {
                    float s0 = bm[(3 * isub) * 2048 + i], s1 = bm[(3 * isub + 1) * 2048 + i];
#pragma unroll
                    for (int q = 0; q < 4; ++q) { s0 += modp[(size_t)(q * 5 + c0) * NMOD + (3 * isub) * 2048 + i]; s1 += modp[(size_t)(q * 5 + c0) * NMOD + (3 * isub + 1) * 2048 + i]; }
                    gs[i] = ng[i] * (1.0f + s1); sh[i] = s0;
                }
                __syncthreads();
                cur = c0;
            }
            const size_t xo = (row < MC ? (size_t)row : (size_t)(row - MC)) * D; const void* xb = row < MC ? xc : xl;
            f32x4 v[8][2]; float ss = 0.f;
#pragma unroll
            for (int j = 0; j < 8; ++j) { const int cidx = 8 * hl + 256 * j;
                if constexpr (XF32) { v[j][0] = *(const f32x4*)((const float*)xb + xo + cidx); v[j][1] = *(const f32x4*)((const float*)xb + xo + cidx + 4); }
                else { const u32x4 w = *(const u32x4*)((const bf16_t*)xb + pg8::blk_off(row < MC ? row : row - MC, cidx, D));
                    v[j][0] = (f32x4){__uint_as_float(w.x << 16), __uint_as_float(w.x & 0xffff0000u), __uint_as_float(w.y << 16), __uint_as_float(w.y & 0xffff0000u)};
                    v[j][1] = (f32x4){__uint_as_float(w.z << 16), __uint_as_float(w.z & 0xffff0000u), __uint_as_float(w.w << 16), __uint_as_float(w.w & 0xffff0000u)}; }
#pragma unroll
                for (int e = 0; e < 2; ++e) ss += (v[j][e].x * v[j][e].x + v[j][e].y * v[j][e].y) + (v[j][e].z * v[j][e].z + v[j][e].w * v[j][e].w); }
#pragma unroll
            for (int o = 1; o < 32; o <<= 1) ss += __shfl_xor(ss, o);
            const float rstd = __builtin_amdgcn_rsqf(ss * (1.0f / D) + 1e-6f);
#pragma unroll
            for (int j = 0; j < 8; ++j) { const int cidx = 8 * hl + 256 * j;
                const f32x4 g0 = *(LAS f32x4*)(gs + cidx), g1 = *(LAS f32x4*)(gs + cidx + 4), s0 = *(LAS f32x4*)(sh + cidx), s1 = *(LAS f32x4*)(sh + cidx + 4);
                const f32x4 o0 = v[j][0] * rstd * g0 + s0, o1 = v[j][1] * rstd * g1 + s1;
                u32x4 w; w.x = pk2(o0.x, o0.y); w.y = pk2(o0.z, o0.w); w.z = pk2(o1.x, o1.y); w.w = pk2(o1.z, o1.w);
                *(u32x4*)(H + pg8::blk_off(row, cidx, D)) = w; }
        }
        __syncthreads();
    }
}
__device__ __forceinline__ void final_phase(const Frame& F, CParams p) {
    const bf16_t* X = (const bf16_t*)(p->ws + WS_X);
    const int gw = F.bid * NWAVES + F.wave, NGW = F.G * NWAVES;
    for (int row = gw; row < M; row += NGW) {
        const bf16_t* xr = X + (size_t)row * D; float* orow = p->out + (size_t)row * D;
        f32x4 v[8]; float ss = 0.f;
#pragma unroll
        for (int j = 0; j < 8; ++j) { v[j] = ld4bf(X + pg8::blk_off(row, 4 * F.lane + 256 * j, D)); ss += (v[j].x * v[j].x + v[j].y * v[j].y) + (v[j].z * v[j].z + v[j].w * v[j].w); }
        const float rstd = __builtin_amdgcn_rsqf(wave_sum(ss) * (1.0f / D) + 1e-6f);
#pragma unroll
        for (int j = 0; j < 8; ++j) { const int cidx = 4 * F.lane + 256 * j; const f32x4 g4 = *(const f32x4*)(p->final_g + cidx); *(f32x4*)(orow + cidx) = v[j] * rstd * g4; }
    }
}

__device__ __forceinline__ void sgu_prep8(const Frame& F, CParams p, int l, int row0) {
    const bf16_t* Z = (const bf16_t*)(p->ws + WS_Z);
    bf16_t* U = (bf16_t*)(p->ws + WS_U); bf16_t* VNT = (bf16_t*)(p->ws + WS_VNT);
    f32x4 gv[8][2]; float mean[8], rstd[8];
#define UNP8(w_, lo_, hi_) do { lo_ = (f32x4){__uint_as_float(w_.x << 16), __uint_as_float(w_.x & 0xffff0000u), __uint_as_float(w_.y << 16), __uint_as_float(w_.y & 0xffff0000u)}; \
                                 hi_ = (f32x4){__uint_as_float(w_.z << 16), __uint_as_float(w_.z & 0xffff0000u), __uint_as_float(w_.w << 16), __uint_as_float(w_.w & 0xffff0000u)}; } while (0)
#pragma unroll
    for (int j = 0; j < 8; ++j) {
        const bf16_t* zr = Z + (size_t)(row0 + j) * NINP;
        const u32x4 wu = *(const u32x4*)(zr + 8 * F.lane), wv = *(const u32x4*)(zr + 512 + 8 * F.lane);
        f32x4 a0, a1, b0, b1; UNP8(wu, a0, a1); UNP8(wv, b0, b1);
        u32x4 w; w.x = pk2(fgelu(a0.x), fgelu(a0.y)); w.y = pk2(fgelu(a0.z), fgelu(a0.w)); w.z = pk2(fgelu(a1.x), fgelu(a1.y)); w.w = pk2(fgelu(a1.z), fgelu(a1.w));
        *(u32x4*)(U + (size_t)(row0 + j) * 512 + 8 * F.lane) = w;
        f32x4 g0, g1; g0.x = fgelu(b0.x); g0.y = fgelu(b0.y); g0.z = fgelu(b0.z); g0.w = fgelu(b0.w); g1.x = fgelu(b1.x); g1.y = fgelu(b1.y); g1.z = fgelu(b1.z); g1.w = fgelu(b1.w);
        gv[j][0] = g0; gv[j][1] = g1;
        const float s = ((g0.x + g0.y) + (g0.z + g0.w)) + ((g1.x + g1.y) + (g1.z + g1.w));
        const float mu = wave_sum(s) * (1.0f / 512.0f); float q = 0.f;
#pragma unroll
        for (int i = 0; i < 2; ++i) { const f32x4 d = gv[j][i] - mu; q += (d.x * d.x + d.y * d.y) + (d.z * d.z + d.w * d.w); }
        mean[j] = mu; rstd[j] = __builtin_amdgcn_rsqf(wave_sum(q) * (1.0f / 512.0f) + 1e-5f);
    }
#undef UNP8
    const int chunk = row0 >> 7, s0 = row0 & 127;
    const float* lg = p->sgu_ln_g + l * 512; const float* lb = p->sgu_ln_b + l * 512;
#pragma unroll
    for (int i = 0; i < 2; ++i) {
        const int ch0 = 8 * F.lane + 4 * i;
        const f32x4 g4 = *(const f32x4*)(lg + ch0), b4 = *(const f32x4*)(lb + ch0);
#pragma unroll
        for (int e = 0; e < 4; ++e) {
            float o[8];
#pragma unroll
            for (int j = 0; j < 8; ++j) o[j] = (gv[j][i][e] - mean[j]) * rstd[j] * g4[e] + b4[e];
            u32x4 w; w.x = pk2(o[0], o[1]); w.y = pk2(o[2], o[3]); w.z = pk2(o[4], o[5]); w.w = pk2(o[6], o[7]);
            *(u32x4*)(VNT + ((size_t)chunk * 512 + ch0 + e) * 128 + s0) = w;
        }
    }
}
__device__ __forceinline__ void rwkv_elem_row(const Frame& F, CParams p, int l, int row) {
    unsigned char* ws = p->ws;
    const bf16_t* Z = (const bf16_t*)(ws + WS_Z);
    float* R = (float*)(ws + WS_SC); float* Kb = R + (size_t)M * CW; float* V = Kb + (size_t)M * CW;
    float* INVN = (float*)(ws + WS_INVN);
    bf16_t* TW = (bf16_t*)(ws + WS_TW); bf16_t* AD = (bf16_t*)(ws + WS_AD); bf16_t* GS = (bf16_t*)(ws + WS_GS);
    const float* mu = p->shift_mu + (size_t)l * CIN; const float* kkp = p->k_k + l * CW;
    int s0, s1, s2, s3, lim1, lim2, lim3;
    if (row < MC) { const int pos = row & 255; s0 = pos > 0 ? row - 1 : -1; s1 = pos < 255 ? row + 1 : -1; s2 = s1; s3 = s1; lim1 = 218; lim2 = 218; lim3 = 218; }
    else { const int pos = (row - MC) & 1023, gc = pos & 63, gr = pos >> 6;
        s0 = gc > 0 ? row - 1 : -1; s1 = gc < 63 ? row + 1 : -1; s2 = gr > 0 ? row - 64 : -1; s3 = gr < 15 ? row + 64 : -1; lim1 = 109; lim2 = 218; lim3 = 327; }
    const bf16_t* zr = Z + (size_t)row * NINP + ZC0;
    u32x4 zcv[7], zsv[7];
#pragma unroll
    for (int it = 0; it < 7; ++it) {
        const int i8 = it * 64 + F.lane; const bool on = (it < 6) || (F.lane < 52);
        const int src = i8 < lim1 ? s0 : (i8 < lim2 ? s1 : (i8 < lim3 ? s2 : s3));
        zcv[it] = (u32x4){0u, 0u, 0u, 0u}; zsv[it] = (u32x4){0u, 0u, 0u, 0u};
        if (on) { zcv[it] = *(const u32x4*)(zr + 8 * i8); if (src >= 0) zsv[it] = *(const u32x4*)(Z + (size_t)src * NINP + ZC0 + 8 * i8); }
    }
    asm volatile("" ::: "memory");
#define ZMIX8(it_, i8_, lo_, hi_) do { const int i8q = (i8_); const u32x4 zc_ = zcv[it_], zs_ = zsv[it_]; \
        const f32x4 m0_ = *(const f32x4*)(mu + 8 * i8q), m1_ = *(const f32x4*)(mu + 8 * i8q + 4); \
        const f32x4 c0_ = (f32x4){__uint_as_float(zc_.x << 16), __uint_as_float(zc_.x & 0xffff0000u), __uint_as_float(zc_.y << 16), __uint_as_float(zc_.y & 0xffff0000u)}; \
        const f32x4 c1_ = (f32x4){__uint_as_float(zc_.z << 16), __uint_as_float(zc_.z & 0xffff0000u), __uint_as_float(zc_.w << 16), __uint_as_float(zc_.w & 0xffff0000u)}; \
        const f32x4 n0_ = (f32x4){__uint_as_float(zs_.x << 16), __uint_as_float(zs_.x & 0xffff0000u), __uint_as_float(zs_.y << 16), __uint_as_float(zs_.y & 0xffff0000u)}; \
        const f32x4 n1_ = (f32x4){__uint_as_float(zs_.z << 16), __uint_as_float(zs_.z & 0xffff0000u), __uint_as_float(zs_.w << 16), __uint_as_float(zs_.w & 0xffff0000u)}; \
        lo_ = c0_ + (n0_ - c0_) * m0_; hi_ = c1_ + (n1_ - c1_) * m1_; } while (0)
#pragma unroll
    for (int it = 0; it < 2; ++it) { const int i8 = it * 64 + F.lane; f32x4 a, b; ZMIX8(it, i8, a, b); float* o = R + (size_t)row * CW + 8 * i8; *(f32x4*)o = a; *(f32x4*)(o + 4) = b; }
#pragma unroll
    for (int it = 0; it < 2; ++it) {
        const int i8 = 128 + it * 64 + F.lane, c = 8 * (i8 - 128); f32x4 a, b; ZMIX8(2 + it, i8, a, b);
        float* o = Kb + (size_t)row * CW + c; *(f32x4*)o = a; *(f32x4*)(o + 4) = b;
        const f32x4 ka = a * *(const f32x4*)(kkp + c), kb = b * *(const f32x4*)(kkp + c + 4);
        float ss = ((ka.x * ka.x + ka.y * ka.y) + (ka.z * ka.z + ka.w * ka.w)) + ((kb.x * kb.x + kb.y * kb.y) + (kb.z * kb.z + kb.w * kb.w));
        ss += __shfl_xor(ss, 1); ss += __shfl_xor(ss, 2); ss += __shfl_xor(ss, 4);
        const float invn = frcp(fmaxf(sqrtf(ss), 1e-12f));
        if ((F.lane & 7) == 0) INVN[(size_t)row * 16 + it * 8 + (F.lane >> 3)] = invn;
    }
#pragma unroll
    for (int it = 0; it < 2; ++it) { const int i8 = 256 + it * 64 + F.lane; f32x4 a, b; ZMIX8(4 + it, i8, a, b); float* o = V + (size_t)row * CW + 8 * (i8 - 256); *(f32x4*)o = a; *(f32x4*)(o + 4) = b; }
    if (F.lane < 52) {
        const int i8 = 384 + F.lane; f32x4 a, b; ZMIX8(6, i8, a, b); u32x4 w;
        if (F.lane < 16) { w.x = pk2(ftanh(a.x), ftanh(a.y)); w.y = pk2(ftanh(a.z), ftanh(a.w)); w.z = pk2(ftanh(b.x), ftanh(b.y)); w.w = pk2(ftanh(b.z), ftanh(b.w)); *(u32x4*)(TW + (size_t)row * 128 + 8 * F.lane) = w; }
        else if (F.lane < 32) { w.x = pk2(a.x, a.y); w.y = pk2(a.z, a.w); w.z = pk2(b.x, b.y); w.w = pk2(b.z, b.w); *(u32x4*)(AD + (size_t)row * 128 + 8 * (F.lane - 16)) = w; }
        else { w.x = pk2(fsigmoid(a.x), fsigmoid(a.y)); w.y = pk2(fsigmoid(a.z), fsigmoid(a.w)); w.z = pk2(fsigmoid(b.x), fsigmoid(b.y)); w.w = pk2(fsigmoid(b.z), fsigmoid(b.w)); *(u32x4*)(GS + (size_t)row * 160 + 8 * (F.lane - 32)) = w; }
    }
#undef ZMIX8
}
template <int CTRL> __device__ __forceinline__ float dppf0(float x) { return __builtin_bit_cast(float, __builtin_amdgcn_update_dpp(0, __builtin_bit_cast(int, x), CTRL, 0xf, 0xf, true)); }
template <int CTRL> __device__ __forceinline__ f32x4 dppv(f32x4 x) { f32x4 r; r.x = dppf0<CTRL>(x.x); r.y = dppf0<CTRL>(x.y); r.z = dppf0<CTRL>(x.z); r.w = dppf0<CTRL>(x.w); return r; }
template <int MT> __device__ __forceinline__ void lowrank_tile(const Frame& F, CParams p, int l, int tok0, const LAS float* biasL) {
    unsigned char* ws = p->ws;
    const int fr = F.lane & 15, fq = F.lane >> 4;
    bf16x8 wf[2][4], af[2][MT];
#define LR_LOAD(g_, w_, a_) do { const int td_ = (g_) >> 1, nh_ = (g_) & 1, ty_ = td_ >> 1, dr_ = td_ & 1; \
        const bf16_t* Wt_ = (const bf16_t*)(ws + (ty_ == 0 ? WS_W2T : WS_A2T)) + (size_t)(l * 2 + dr_) * CW * 64 + (size_t)(128 * F.wave + 64 * nh_ + fr) * 64 + 8 * fq; \
        const bf16_t* Ac_ = (const bf16_t*)(ws + (ty_ == 0 ? WS_TW : WS_AD)) + (size_t)(tok0 + fr) * 128 + dr_ * 64 + 8 * fq; \
        _Pragma("unroll") for (int ks = 0; ks < 2; ++ks) { \
            _Pragma("unroll") for (int nt = 0; nt < 4; ++nt) w_[ks][nt] = *(const bf16x8*)(Wt_ + (size_t)(nt * 16) * 64 + ks * 32); \
            _Pragma("unroll") for (int mt = 0; mt < MT; ++mt) a_[ks][mt] = *(const bf16x8*)(Ac_ + (size_t)(mt * 16) * 128 + ks * 32); } } while (0)
    LR_LOAD(0, wf, af);
#define LR_USE() do { _Pragma("unroll") for (int ks = 0; ks < 2; ++ks) { _Pragma("unroll") for (int nt = 0; nt < 4; ++nt) asm volatile("" :: "v"(wf[ks][nt])); _Pragma("unroll") for (int mt = 0; mt < MT; ++mt) asm volatile("" :: "v"(af[ks][mt])); } } while (0)
    LR_USE();
#pragma unroll 1
    for (int g = 0; g < 8; ++g) {
        const int td = g >> 1, nh = g & 1, type = td >> 1, dir = td & 1;
        const LAS float* bias = biasL + td * CW;
        float* Out = (float*)(ws + WS_SC + (size_t)(3 + type * 2 + dir) * SC_ARR);
        {
            const int n0 = 128 * F.wave + 64 * nh;
            f32x4 acc[MT][4];
#pragma unroll
            for (int a = 0; a < MT; ++a)
#pragma unroll
                for (int b = 0; b < 4; ++b) acc[a][b] = (f32x4){0.f, 0.f, 0.f, 0.f};
#pragma unroll
            for (int ks = 0; ks < 2; ++ks)
#pragma unroll
                for (int mt = 0; mt < MT; ++mt)
#pragma unroll
                    for (int nt = 0; nt < 4; ++nt) acc[mt][nt] = MFMA16(wf[ks][nt], af[ks][mt], acc[mt][nt]);
            { const int gn = g < 7 ? g + 1 : 7; LR_LOAD(gn, wf, af); }
            __builtin_amdgcn_sched_barrier(0);
#pragma unroll
            for (int nt = 0; nt < 4; ++nt) {
                const int n = n0 + nt * 16 + 4 * fq;
                const f32x4 b4 = *(const LAS f32x4*)(bias + n);
#pragma unroll
                for (int mt = 0; mt < MT; ++mt) {
                    const f32x4 x = acc[mt][nt] + b4; f32x4 o;
                    if (type == 0) {
                        o.x = 0.875f * fsigmoid(x.x); o.y = 0.875f * fsigmoid(x.y); o.z = 0.875f * fsigmoid(x.z); o.w = 0.875f * fsigmoid(x.w);
                        o = o * 1.0000284f;
                        if (dir == 0) { o = o + dppv<0x111>(o); o = o + dppv<0x112>(o); o = o + dppv<0x114>(o); o = o + dppv<0x118>(o); }
                        else          { o = o + dppv<0x101>(o); o = o + dppv<0x102>(o); o = o + dppv<0x104>(o); o = o + dppv<0x108>(o); }
                    }
                    else { o.x = fsigmoid(x.x); o.y = fsigmoid(x.y); o.z = fsigmoid(x.z); o.w = fsigmoid(x.w); }
                    *(f32x4*)(Out + (size_t)(tok0 + mt * 16 + fr) * CW + n) = o;
                }
            }
        }
        LR_USE();
    }
#undef LR_USE
#undef LR_LOAD
    {
        const bf16_t* Wt = (const bf16_t*)(ws + WS_G2T) + (size_t)l * CW * 160;
        const bf16_t* Act = (const bf16_t*)(ws + WS_GS);
        bf16_t* G = (bf16_t*)(ws + WS_G);
#pragma unroll
        for (int nh = 0; nh < 2; ++nh) {
            const int n0 = 128 * F.wave + 64 * nh;
            f32x4 acc[MT][4];
#pragma unroll
            for (int a = 0; a < MT; ++a)
#pragma unroll
                for (int b = 0; b < 4; ++b) acc[a][b] = (f32x4){0.f, 0.f, 0.f, 0.f};
#pragma unroll
            for (int ks = 0; ks < 5; ++ks) {
                bf16x8 wf[4], af[MT];
#pragma unroll
                for (int nt = 0; nt < 4; ++nt) wf[nt] = *(const bf16x8*)(Wt + (size_t)(n0 + nt * 16 + fr) * 160 + ks * 32 + 8 * fq);
#pragma unroll
                for (int mt = 0; mt < MT; ++mt) af[mt] = *(const bf16x8*)(Act + (size_t)(tok0 + mt * 16 + fr) * 160 + ks * 32 + 8 * fq);
#pragma unroll
                for (int mt = 0; mt < MT; ++mt)
#pragma unroll
                    for (int nt = 0; nt < 4; ++nt) acc[mt][nt] = MFMA16(wf[nt], af[mt], acc[mt][nt]);
            }
#pragma unroll
            for (int nt = 0; nt < 4; ++nt)
#pragma unroll
                for (int mt = 0; mt < MT; ++mt) { const f32x4 x = acc[mt][nt]; u32x2 w; w.x = pk2(x.x, x.y); w.y = pk2(x.z, x.w);
                    *(u32x2*)(G + (size_t)(tok0 + mt * 16 + fr) * CW + n0 + nt * 16 + 4 * fq) = w; }
        }
    }
}
__device__ __forceinline__ void fnet_local_unit(const Frame& F, CParams p, int u) {
    unsigned char* ws = p->ws;
    const bf16_t* Z = (const bf16_t*)(ws + WS_Z);
    const bf16_t* CS = (const bf16_t*)(ws + WS_CS128);
    const int fr = F.lane & 15, fq = F.lane >> 4;
    int L, seqrow0, g, mt, st; bf16_t* tb;
    if (u < 2048) { const int b = u >> 6; g = (u >> 4) & 3; mt = (u >> 2) & 3; st = u & 3; L = 256; seqrow0 = b * 256; tb = (bf16_t*)(ws + WS_TTB) + (size_t)(b * 512) * 512; }
    else { const int v = u - 2048, b = v >> 8; g = (v >> 6) & 3; mt = (v >> 4) & 3; st = v & 15; L = 1024; seqrow0 = MC + b * 1024;
        tb = (bf16_t*)(ws + WS_TTB) + (size_t)32 * 4 * 128 * 512 + (size_t)(b * 512) * 2048; }
    f32x4 acc[4][4];
#pragma unroll
    for (int a = 0; a < 4; ++a)
#pragma unroll
        for (int b = 0; b < 4; ++b) acc[a][b] = (f32x4){0.f, 0.f, 0.f, 0.f};
#pragma unroll
    for (int ks = 0; ks < 4; ++ks) {
        bf16x8 cf[4], xf[4];
#pragma unroll
        for (int mi = 0; mi < 4; ++mi) cf[mi] = *(const bf16x8*)(CS + (size_t)(64 * mt + 16 * mi + fr) * 128 + 32 * ks + 8 * fq);
#pragma unroll
        for (int si = 0; si < 4; ++si) xf[si] = *(const bf16x8*)(Z + (size_t)(seqrow0 + 64 * st + 16 * si + fr) * NINP + 1024 + g * 128 + 32 * ks + 8 * fq);
#pragma unroll
        for (int mi = 0; mi < 4; ++mi)
#pragma unroll
            for (int si = 0; si < 4; ++si) acc[mi][si] = MFMA16(xf[si], cf[mi], acc[mi][si]);
    }
    const int cs = mt >> 1;
#pragma unroll
    for (int mi = 0; mi < 4; ++mi) {
        const int dp = (mt & 1) * 64 + 16 * mi + fr;
#pragma unroll
        for (int si = 0; si < 4; ++si) { const f32x4 x = acc[mi][si]; u32x2 w; w.x = pk2(x.x, x.y); w.y = pk2(x.z, x.w);
            *(u32x2*)(tb + frag_addr(g * 128 + dp, cs * L + 64 * st + 16 * si + 4 * fq, 2 * L)) = w; }
    }
}
__device__ __forceinline__ void mixprep_phase(const Frame& F, CParams p, int l) {
    LAS float* biasL = (LAS float*)F.lds;
    for (int i = F.tid; i < 4 * CW / 4; i += NTHR) { const int td = i >> 8, j4 = i & 255;
        *(LAS f32x4*)(biasL + td * CW + 4 * j4) = *(const f32x4*)(((td >> 1) == 0 ? p->decay_w0 : p->iclr_a0) + (size_t)(l * 2 + (td & 1)) * CW + 4 * j4); }
    __syncthreads();
    for (int dupa = 0; dupa < DBG_P6A; ++dupa)
    for (int u = F.bid; u < M / 48; u += F.G) {
        const int tok0 = u * 48, row0 = tok0 + 6 * F.wave;
        for (int dr = 0; dr < DBG_P6R; ++dr)
#pragma unroll 1
        for (int j = 0; j < 6; ++j) rwkv_elem_row(F, p, l, row0 + j);
        asm volatile("s_waitcnt vmcnt(0)" ::: "memory");
        __syncthreads();
        for (int dl = 0; dl < DBG_P6L; ++dl) lowrank_tile<3>(F, p, l, tok0, biasL);
    }
    const int NGW = F.G * NWAVES, gw = F.bid * NWAVES + F.wave;
    for (int dupb = 0; dupb < DBG_P6B; ++dupb)
    for (int u = gw; u < M / 8 + 3072; u += NGW) {
        if (u < M / 8) sgu_prep8(F, p, l, 8 * u); else fnet_local_unit(F, p, u - M / 8);
    }
}

#if defined(DBG_SAFE_DPP)
#define DPP_BC(J, x) __builtin_bit_cast(float, __builtin_amdgcn_update_dpp(0, __builtin_bit_cast(int, (x)), 0x150 + (J), 0xf, 0xf, true))
#define DPP_FMAC(J, acc, vec, s) acc = fmaf(DPP_BC(J, vec), (s), acc)
#define DPP_MUL(J, dst, vec, s) dst = DPP_BC(J, vec) * (s)
#else
#define DPP_FMAC(J, acc, vec, s) asm("v_fmac_f32_dpp %0, %1, %2 row_newbcast:" #J " row_mask:0xf bank_mask:0xf" : "+v"(acc) : "v"(vec), "v"(s))
#define DPP_MUL(J, dst, vec, s) asm("v_mul_f32_dpp %0, %1, %2 row_newbcast:" #J " row_mask:0xf bank_mask:0xf" : "=v"(dst) : "v"(vec), "v"(s))
#endif
__device__ __forceinline__ float segsum(float x) {
#if defined(DBG_SAFE_SEGSUM)
    x += __shfl_xor(x, 16); x += __shfl_xor(x, 32); return x;
#elif !defined(DBG_BUILTIN_SWAP)
    float t;
    asm volatile("v_mov_b32 %1, %0\n\ts_nop 1\n\tv_permlane32_swap_b32 %0, %1\n\ts_nop 1\n\tv_add_f32 %0, %0, %1\n\tv_mov_b32 %1, %0\n\ts_nop 1\n\tv_permlane16_swap_b32 %0, %1\n\ts_nop 1\n\tv_add_f32 %0, %0, %1"
                 : "+v"(x), "=&v"(t));
    return x;
#endif
    const unsigned xu = __float_as_uint(x);
    const auto r = __builtin_amdgcn_permlane32_swap(xu, xu, false, false);
    const float s = __uint_as_float(r[0]) + __uint_as_float(r[1]);
    const unsigned su = __float_as_uint(s);
    const auto q = __builtin_amdgcn_permlane16_swap(su, su, false, false);
    return __uint_as_float(q[0]) + __uint_as_float(q[1]);
}
struct ScanIn { float k, r, a, d, nv, v; };
__device__ __forceinline__ void scan_job(const Frame& F, CParams p, int l, int job) {
    unsigned char* ws = p->ws;
    const bool lat = job < 512; const int q = lat ? job : job - 512;
    const int chain = q >> 2, rb = q & 3, b = chain >> 5, h = (chain & 31) >> 1, dir = chain & 1;
    const int L = lat ? 1024 : 256, base = lat ? MC + b * 1024 : b * 256;
    const int seg = F.lane >> 4, li = F.lane & 15;
    const size_t srow = ((size_t)(((b * 2 + l) * 2 + dir) * 16 + h) * 64 + 16 * rb + li) * 64 + 16 * seg;
    float S[16];
    if (lat) {
        const float* s0 = p->state_wkv + srow;
#pragma unroll
        for (int j = 0; j < 4; ++j) { const f32x4 t = *(const f32x4*)(s0 + 4 * j); S[4 * j] = t.x; S[4 * j + 1] = t.y; S[4 * j + 2] = t.z; S[4 * j + 3] = t.w; }
    } else {
#pragma unroll
        for (int j = 0; j < 16; ++j) S[j] = 0.f;
    }
    const float* R = (const float*)(ws + WS_SC); const float* Kb = R + (size_t)M * CW; const float* V = Kb + (size_t)M * CW;
    const float* DEC = R + (size_t)(3 + dir) * M * CW; const float* A = R + (size_t)(5 + dir) * M * CW;
    const float* INVN = (const float*)(ws + WS_INVN);
    float* Y = (float*)(ws + WS_Z) + (size_t)dir * M * CW;
    const unsigned col = h * 64 + F.lane, vcol = h * 64 + 16 * rb + li;
    const float kkc = p->k_k[l * CW + col], kac = p->k_a[l * CW + col];
    const int rstep = dir ? -1 : 1, rfirst = dir ? base + L - 1 : base;
#define SCAN_LOAD(dst, t_) do { const int tq_ = (t_) < L ? (t_) : L - 1; const size_t ro_ = (size_t)(unsigned)__builtin_amdgcn_readfirstlane(rfirst + rstep * tq_); \
        const float* kr_ = Kb + ro_ * CW; const float* rr_ = R + ro_ * CW; const float* ar_ = A + ro_ * CW; const float* dr_ = DEC + ro_ * CW; const float* vr_ = V + ro_ * CW; \
        dst.k = kr_[col]; dst.r = rr_[col]; dst.a = ar_[col]; dst.d = dr_[col]; dst.nv = INVN[ro_ * 16 + h]; dst.v = vr_[vcol]; } while (0)
#if defined(DBG_STUB_SCAN)
    for (int t = 0; t < L; ++t) if (F.lane < 16) Y[(size_t)(rfirst + rstep * t) * CW + vcol] = 0.f;
    if (0) {
#else
    {
#endif
    if (lat) __builtin_amdgcn_s_setprio(LAT_PRIO);
#define SCAN_SA_ASM() asm("v_fmac_f32_dpp %[a0], %[kk], %[s0] row_newbcast:0 row_mask:0xf bank_mask:0xf\n\tv_fmac_f32_dpp %[a1], %[kk], %[s1] row_newbcast:1 row_mask:0xf bank_mask:0xf\n\tv_fmac_f32_dpp %[a0], %[kk], %[s2] row_newbcast:2 row_mask:0xf bank_mask:0xf\n\tv_fmac_f32_dpp %[a1], %[kk], %[s3] row_newbcast:3 row_mask:0xf bank_mask:0xf\n\tv_fmac_f32_dpp %[a0], %[kk], %[s4] row_newbcast:4 row_mask:0xf bank_mask:0xf\n\tv_fmac_f32_dpp %[a1], %[kk], %[s5] row_newbcast:5 row_mask:0xf bank_mask:0xf\n\tv_fmac_f32_dpp %[a0], %[kk], %[s6] row_newbcast:6 row_mask:0xf bank_mask:0xf\n\tv_fmac_f32_dpp %[a1], %[kk], %[s7] row_newbcast:7 row_mask:0xf bank_mask:0xf\n\tv_fmac_f32_dpp %[a0], %[kk], %[s8] row_newbcast:8 row_mask:0xf bank_mask:0xf\n\tv_fmac_f32_dpp %[a1], %[kk], %[s9] row_newbcast:9 row_mask:0xf bank_mask:0xf\n\tv_fmac_f32_dpp %[a0], %[kk], %[s10] row_newbcast:10 row_mask:0xf bank_mask:0xf\n\tv_fmac_f32_dpp %[a1], %[kk], %[s11] row_newbcast:11 row_mask:0xf bank_mask:0xf\n\tv_fmac_f32_dpp %[a0], %[kk], %[s12] row_newbcast:12 row_mask:0xf bank_mask:0xf\n\tv_fmac_f32_dpp %[a1], %[kk], %[s13] row_newbcast:13 row_mask:0xf bank_mask:0xf\n\tv_fmac_f32_dpp %[a0], %[kk], %[s14] row_newbcast:14 row_mask:0xf bank_mask:0xf\n\tv_fmac_f32_dpp %[a1], %[kk], %[s15] row_newbcast:15 row_mask:0xf bank_mask:0xf" : [a0] "+v"(sa0), [a1] "+v"(sa1) : [s0] "v"(S[0]), [s1] "v"(S[1]), [s2] "v"(S[2]), [s3] "v"(S[3]), [s4] "v"(S[4]), [s5] "v"(S[5]), [s6] "v"(S[6]), [s7] "v"(S[7]), [s8] "v"(S[8]), [s9] "v"(S[9]), [s10] "v"(S[10]), [s11] "v"(S[11]), [s12] "v"(S[12]), [s13] "v"(S[13]), [s14] "v"(S[14]), [s15] "v"(S[15]), [kk] "v"(kkv))
#define SCAN_UPD_ASM_LO() asm("v_mul_f32_dpp %[s0], %[d], %[s0] row_newbcast:0 row_mask:0xf bank_mask:0xf\n\tv_mul_f32_dpp %[s1], %[d], %[s1] row_newbcast:1 row_mask:0xf bank_mask:0xf\n\tv_mul_f32_dpp %[s2], %[d], %[s2] row_newbcast:2 row_mask:0xf bank_mask:0xf\n\tv_mul_f32_dpp %[s3], %[d], %[s3] row_newbcast:3 row_mask:0xf bank_mask:0xf\n\tv_mul_f32_dpp %[s4], %[d], %[s4] row_newbcast:4 row_mask:0xf bank_mask:0xf\n\tv_mul_f32_dpp %[s5], %[d], %[s5] row_newbcast:5 row_mask:0xf bank_mask:0xf\n\tv_mul_f32_dpp %[s6], %[d], %[s6] row_newbcast:6 row_mask:0xf bank_mask:0xf\n\tv_mul_f32_dpp %[s7], %[d], %[s7] row_newbcast:7 row_mask:0xf bank_mask:0xf\n\tv_fmac_f32_dpp %[s0], %[ka], %[nsa] row_newbcast:0 row_mask:0xf bank_mask:0xf\n\tv_fmac_f32_dpp %[s1], %[ka], %[nsa] row_newbcast:1 row_mask:0xf bank_mask:0xf\n\tv_fmac_f32_dpp %[s2], %[ka], %[nsa] row_newbcast:2 row_mask:0xf bank_mask:0xf\n\tv_fmac_f32_dpp %[s3], %[ka], %[nsa] row_newbcast:3 row_mask:0xf bank_mask:0xf\n\tv_fmac_f32_dpp %[s4], %[ka], %[nsa] row_newbcast:4 row_mask:0xf bank_mask:0xf\n\tv_fmac_f32_dpp %[s5], %[ka], %[nsa] row_newbcast:5 row_mask:0xf bank_mask:0xf\n\tv_fmac_f32_dpp %[s6], %[ka], %[nsa] row_newbcast:6 row_mask:0xf bank_mask:0xf\n\tv_fmac_f32_dpp %[s7], %[ka], %[nsa] row_newbcast:7 row_mask:0xf bank_mask:0xf\n\tv_fmac_f32_dpp %[s0], %[km], %[vv] row_newbcast:0 row_mask:0xf bank_mask:0xf\n\tv_fmac_f32_dpp %[s1], %[km], %[vv] row_newbcast:1 row_mask:0xf bank_mask:0xf\n\tv_fmac_f32_dpp %[s2], %[km], %[vv] row_newbcast:2 row_mask:0xf bank_mask:0xf\n\tv_fmac_f32_dpp %[s3], %[km], %[vv] row_newbcast:3 row_mask:0xf bank_mask:0xf\n\tv_fmac_f32_dpp %[s4], %[km], %[vv] row_newbcast:4 row_mask:0xf bank_mask:0xf\n\tv_fmac_f32_dpp %[s5], %[km], %[vv] row_newbcast:5 row_mask:0xf bank_mask:0xf\n\tv_fmac_f32_dpp %[s6], %[km], %[vv] row_newbcast:6 row_mask:0xf bank_mask:0xf\n\tv_fmac_f32_dpp %[s7], %[km], %[vv] row_newbcast:7 row_mask:0xf bank_mask:0xf\n\tv_fmac_f32_dpp %[y0], %[r], %[s0] row_newbcast:0 row_mask:0xf bank_mask:0xf\n\tv_fmac_f32_dpp %[y1], %[r], %[s1] row_newbcast:1 row_mask:0xf bank_mask:0xf\n\tv_fmac_f32_dpp %[y0], %[r], %[s2] row_newbcast:2 row_mask:0xf bank_mask:0xf\n\tv_fmac_f32_dpp %[y1], %[r], %[s3] row_newbcast:3 row_mask:0xf bank_mask:0xf\n\tv_fmac_f32_dpp %[y0], %[r], %[s4] row_newbcast:4 row_mask:0xf bank_mask:0xf\n\tv_fmac_f32_dpp %[y1], %[r], %[s5] row_newbcast:5 row_mask:0xf bank_mask:0xf\n\tv_fmac_f32_dpp %[y0], %[r], %[s6] row_newbcast:6 row_mask:0xf bank_mask:0xf\n\tv_fmac_f32_dpp %[y1], %[r], %[s7] row_newbcast:7 row_mask:0xf bank_mask:0xf" : [s0] "+v"(S[0]), [s1] "+v"(S[1]), [s2] "+v"(S[2]), [s3] "+v"(S[3]), [s4] "+v"(S[4]), [s5] "+v"(S[5]), [s6] "+v"(S[6]), [s7] "+v"(S[7]), [y0] "+v"(y0), [y1] "+v"(y1) : [d] "v"(dv), [ka] "v"(kav), [km] "v"(kmv), [r] "v"(rv), [nsa] "v"(nsa), [vv] "v"(vv))
#define SCAN_UPD_ASM_HI() asm("v_mul_f32_dpp %[s0], %[d], %[s0] row_newbcast:8 row_mask:0xf bank_mask:0xf\n\tv_mul_f32_dpp %[s1], %[d], %[s1] row_newbcast:9 row_mask:0xf bank_mask:0xf\n\tv_mul_f32_dpp %[s2], %[d], %[s2] row_newbcast:10 row_mask:0xf bank_mask:0xf\n\tv_mul_f32_dpp %[s3], %[d], %[s3] row_newbcast:11 row_mask:0xf bank_mask:0xf\n\tv_mul_f32_dpp %[s4], %[d], %[s4] row_newbcast:12 row_mask:0xf bank_mask:0xf\n\tv_mul_f32_dpp %[s5], %[d], %[s5] row_newbcast:13 row_mask:0xf bank_mask:0xf\n\tv_mul_f32_dpp %[s6], %[d], %[s6] row_newbcast:14 row_mask:0xf bank_mask:0xf\n\tv_mul_f32_dpp %[s7], %[d], %[s7] row_newbcast:15 row_mask:0xf bank_mask:0xf\n\tv_fmac_f32_dpp %[s0], %[ka], %[nsa] row_newbcast:8 row_mask:0xf bank_mask:0xf\n\tv_fmac_f32_dpp %[s1], %[ka], %[nsa] row_newbcast:9 row_mask:0xf bank_mask:0xf\n\tv_fmac_f32_dpp %[s2], %[ka], %[nsa] row_newbcast:10 row_mask:0xf bank_mask:0xf\n\tv_fmac_f32_dpp %[s3], %[ka], %[nsa] row_newbcast:11 row_mask:0xf bank_mask:0xf\n\tv_fmac_f32_dpp %[s4], %[ka], %[nsa] row_newbcast:12 row_mask:0xf bank_mask:0xf\n\tv_fmac_f32_dpp %[s5], %[ka], %[nsa] row_newbcast:13 row_mask:0xf bank_mask:0xf\n\tv_fmac_f32_dpp %[s6], %[ka], %[nsa] row_newbcast:14 row_mask:0xf bank_mask:0xf\n\tv_fmac_f32_dpp %[s7], %[ka], %[nsa] row_newbcast:15 row_mask:0xf bank_mask:0xf\n\tv_fmac_f32_dpp %[s0], %[km], %[vv] row_newbcast:8 row_mask:0xf bank_mask:0xf\n\tv_fmac_f32_dpp %[s1], %[km], %[vv] row_newbcast:9 row_mask:0xf bank_mask:0xf\n\tv_fmac_f32_dpp %[s2], %[km], %[vv] row_newbcast:10 row_mask:0xf bank_mask:0xf\n\tv_fmac_f32_dpp %[s3], %[km], %[vv] row_newbcast:11 row_mask:0xf bank_mask:0xf\n\tv_fmac_f32_dpp %[s4], %[km], %[vv] row_newbcast:12 row_mask:0xf bank_mask:0xf\n\tv_fmac_f32_dpp %[s5], %[km], %[vv] row_newbcast:13 row_mask:0xf bank_mask:0xf\n\tv_fmac_f32_dpp %[s6], %[km], %[vv] row_newbcast:14 row_mask:0xf bank_mask:0xf\n\tv_fmac_f32_dpp %[s7], %[km], %[vv] row_newbcast:15 row_mask:0xf bank_mask:0xf\n\tv_fmac_f32_dpp %[y0], %[r], %[s0] row_newbcast:8 row_mask:0xf bank_mask:0xf\n\tv_fmac_f32_dpp %[y1], %[r], %[s1] row_newbcast:9 row_mask:0xf bank_mask:0xf\n\tv_fmac_f32_dpp %[y0], %[r], %[s2] row_newbcast:10 row_mask:0xf bank_mask:0xf\n\tv_fmac_f32_dpp %[y1], %[r], %[s3] row_newbcast:11 row_mask:0xf bank_mask:0xf\n\tv_fmac_f32_dpp %[y0], %[r], %[s4] row_newbcast:12 row_mask:0xf bank_mask:0xf\n\tv_fmac_f32_dpp %[y1], %[r], %[s5] row_newbcast:13 row_mask:0xf bank_mask:0xf\n\tv_fmac_f32_dpp %[y0], %[r], %[s6] row_newbcast:14 row_mask:0xf bank_mask:0xf\n\tv_fmac_f32_dpp %[y1], %[r], %[s7] row_newbcast:15 row_mask:0xf bank_mask:0xf" : [s0] "+v"(S[8]), [s1] "+v"(S[9]), [s2] "+v"(S[10]), [s3] "+v"(S[11]), [s4] "+v"(S[12]), [s5] "+v"(S[13]), [s6] "+v"(S[14]), [s7] "+v"(S[15]), [y0] "+v"(y0), [y1] "+v"(y1) : [d] "v"(dv), [ka] "v"(kav), [km] "v"(kmv), [r] "v"(rv), [nsa] "v"(nsa), [vv] "v"(vv))
#define SCAN_STEP(cur, tcur) do { \
            float kkv = cur.k * kkc * cur.nv, kav = kkv * cur.a, kmv = cur.k + cur.k * (cur.a - 1.0f) * kac, dv = cur.d, rv = cur.r; \
            const float vv = cur.v; \
            asm volatile("s_nop 1" : "+v"(kkv), "+v"(kav), "+v"(kmv), "+v"(dv), "+v"(rv)); \
            float sa0 = 0.f, sa1 = 0.f; \
            SCAN_SA_ASM(); \
            const float nsa = -segsum(sa0 + sa1); \
            float y0 = 0.f, y1 = 0.f; \
            SCAN_UPD_ASM_LO(); SCAN_UPD_ASM_HI(); \
            const float y = segsum(y0 + y1); \
            if (F.lane < 16) Y[(size_t)(rfirst + rstep * (tcur)) * CW + vcol] = y; } while (0)
    ScanIn bA[4], bB[4];
    SCAN_LOAD(bA[0], 0); SCAN_LOAD(bA[1], 1); SCAN_LOAD(bA[2], 2); SCAN_LOAD(bA[3], 3);
    for (int t = 0; t < L; t += 8) {
#pragma unroll
        for (int u = 0; u < 4; ++u) { SCAN_LOAD(bB[u], t + u + 4); SCAN_STEP(bA[u], t + u); }
#pragma unroll
        for (int u = 0; u < 4; ++u) { SCAN_LOAD(bA[u], t + u + 8); SCAN_STEP(bB[u], t + u + 4); }
    }
#undef SCAN_STEP
#undef SCAN_SA_ASM
#undef SCAN_UPD_ASM_LO
#undef SCAN_UPD_ASM_HI
    }
    __builtin_amdgcn_s_setprio(0);
#undef SCAN_LOAD
    if (!lat) {
        float* so = p->out + (size_t)M * D + srow;
#pragma unroll
        for (int j = 0; j < 4; ++j) *(f32x4*)(so + 4 * j) = (f32x4){S[4 * j], S[4 * j + 1], S[4 * j + 2], S[4 * j + 3]};
    }
}
__device__ __forceinline__ void fnet_seq_job(const Frame& F, CParams p, int v, bool lat) {
    unsigned char* ws = p->ws;
    const int fr = F.lane & 15, fq = F.lane >> 4;
    int K2, seqrow0, mt, nt; const bf16_t* tb; const bf16_t* dft;
    if (lat) { const int b = v >> 7; mt = (v >> 3) & 15; nt = v & 7; K2 = 2048; seqrow0 = MC + b * 1024; dft = (const bf16_t*)(ws + WS_DFTL);
        tb = (const bf16_t*)(ws + WS_TTB) + (size_t)32 * 4 * 128 * 512 + (size_t)b * 512 * 2048; }
    else { const int b = v >> 5; mt = (v >> 3) & 3; nt = v & 7; K2 = 512; seqrow0 = b * 256; dft = (const bf16_t*)(ws + WS_DFTC);
        tb = (const bf16_t*)(ws + WS_TTB) + (size_t)b * 512 * 512; }
    const int rs = (K2 >> 5) * 512;
    const bf16_t* pp = tb + (size_t)(4 * nt) * rs + F.lane * 8;
    const bf16_t* qp = dft + (size_t)(4 * mt) * rs + F.lane * 8;
    f32x4 acc[4][4];
#pragma unroll
    for (int a = 0; a < 4; ++a)
#pragma unroll
        for (int b = 0; b < 4; ++b) acc[a][b] = (f32x4){0.f, 0.f, 0.f, 0.f};
    bf16x8 pf[4], qf[4], pn[4], qn[4];
#pragma unroll
    for (int i = 0; i < 4; ++i) { pf[i] = *(const bf16x8*)(pp + (size_t)i * rs); qf[i] = *(const bf16x8*)(qp + (size_t)i * rs); }
    const int nks = K2 / 32;
    for (int ks = 0; ks < nks; ++ks) {
        const int kn = (ks + 1 < nks) ? (ks + 1) * 512 : 0;
#pragma unroll
        for (int i = 0; i < 4; ++i) { pn[i] = *(const bf16x8*)(pp + (size_t)i * rs + kn); qn[i] = *(const bf16x8*)(qp + (size_t)i * rs + kn); }
#pragma unroll
        for (int ni = 0; ni < 4; ++ni)
#pragma unroll
            for (int ti = 0; ti < 4; ++ti) acc[ni][ti] = MFMA16(pf[ni], qf[ti], acc[ni][ti]);
#pragma unroll
        for (int i = 0; i < 4; ++i) { pf[i] = pn[i]; qf[i] = qn[i]; }
    }
    bf16_t* MIX = (bf16_t*)(ws + WS_H);
#pragma unroll
    for (int ti = 0; ti < 4; ++ti) {
        const int mrow = seqrow0 + 64 * mt + 16 * ti + fr;
#pragma unroll
        for (int ni = 0; ni < 4; ++ni) { const f32x4 x = acc[ni][ti]; u32x2 w; w.x = pk2(x.x, x.y); w.y = pk2(x.z, x.w); *(u32x2*)(MIX + pg8::blk_off(mrow, 512 + 64 * nt + 4 * fq + 16 * ni, D)) = w; }
    }
}
__device__ __forceinline__ void sgu_job(const Frame& F, CParams p, int l, int v) {
    unsigned char* ws = p->ws;
    const int fr = F.lane & 15, fq = F.lane >> 4;
    const int chunk = v >> 4, h = (v >> 2) & 3, tt = (v >> 1) & 1, dt = v & 1;
    const bf16_t* pp = (const bf16_t*)(ws + WS_VNT) + ((size_t)chunk * 512 + h * 128 + 64 * dt + fr) * 128 + 8 * fq;
    const bf16_t* qp = (const bf16_t*)(ws + WS_SGUW) + ((size_t)(l * 4 + h) * 128 + 64 * tt + fr) * 128 + 8 * fq;
    f32x4 acc[4][4];
#pragma unroll
    for (int a = 0; a < 4; ++a)
#pragma unroll
        for (int b = 0; b < 4; ++b) acc[a][b] = (f32x4){0.f, 0.f, 0.f, 0.f};
#pragma unroll
    for (int ks = 0; ks < 4; ++ks) {
        bf16x8 pf[4], qf[4];
#pragma unroll
        for (int i = 0; i < 4; ++i) { pf[i] = *(const bf16x8*)(pp + (size_t)(16 * i) * 128 + 32 * ks); qf[i] = *(const bf16x8*)(qp + (size_t)(16 * i) * 128 + 32 * ks); }
#pragma unroll
        for (int di = 0; di < 4; ++di)
#pragma unroll
            for (int ti = 0; ti < 4; ++ti) acc[di][ti] = MFMA16(pf[di], qf[ti], acc[di][ti]);
    }
    const bf16_t* U = (const bf16_t*)(ws + WS_U); bf16_t* MIX = (bf16_t*)(ws + WS_H);
#pragma unroll
    for (int ti = 0; ti < 4; ++ti) {
        const int t = 64 * tt + 16 * ti + fr, token = chunk * 128 + t;
        const float bias = p->sgu_b[(l * 4 + h) * 128 + t];
#pragma unroll
        for (int di = 0; di < 4; ++di) {
            const int ch = h * 128 + 64 * dt + 16 * di + 4 * fq;
            const u32x2 uu = *(const u32x2*)(U + (size_t)token * 512 + ch);
            const f32x4 x = acc[di][ti] + bias;
            const float u0 = __uint_as_float(uu.x << 16), u1 = __uint_as_float(uu.x & 0xffff0000u), u2 = __uint_as_float(uu.y << 16), u3 = __uint_as_float(uu.y & 0xffff0000u);
            u32x2 w; w.x = pk2(u0 * x.x, u1 * x.y); w.y = pk2(u2 * x.z, u3 * x.w);
            *(u32x2*)(MIX + pg8::blk_off(token, ch, D)) = w;
        }
    }
}
typedef short bf16x4 __attribute__((ext_vector_type(4)));
#define MFMA16K(a, b, c) MFMA16(cat44z(a), cat44z(b), (c))
__device__ __forceinline__ bf16x4 pack4(f32x4 x) { u32x2 w; w.x = pk2(x.x, x.y); w.y = pk2(x.z, x.w); return __builtin_bit_cast(bf16x4, w); }
__device__ __forceinline__ bf16x8 pack8(f32x4 lo, f32x4 hi) { u32x4 w; w.x = pk2(lo.x, lo.y); w.y = pk2(lo.z, lo.w); w.z = pk2(hi.x, hi.y); w.w = pk2(hi.z, hi.w); return __builtin_bit_cast(bf16x8, w); }
__device__ __forceinline__ bf16x8 cat44(bf16x4 a, bf16x4 b) { const u32x2 x = __builtin_bit_cast(u32x2, a), y = __builtin_bit_cast(u32x2, b); u32x4 w; w.x = x.x; w.y = x.y; w.z = y.x; w.w = y.y; return __builtin_bit_cast(bf16x8, w); }
__device__ __forceinline__ bf16x8 cat44z(bf16x4 a) { const u32x2 x = __builtin_bit_cast(u32x2, a); u32x4 w; w.x = x.x; w.y = x.y; w.z = 0u; w.w = 0u; return __builtin_bit_cast(bf16x8, w); }
template <int CTRL> __device__ __forceinline__ float dppf(float x) { return __builtin_bit_cast(float, __builtin_amdgcn_update_dpp(0, __builtin_bit_cast(int, x), CTRL, 0xf, 0xf, true)); }
__device__ __forceinline__ float prefix16(float x) {
    x += dppf<0x111>(x); x += dppf<0x112>(x); x += dppf<0x114>(x); x += dppf<0x118>(x); return x;
}
__device__ __forceinline__ f32x4 prefix16v(f32x4 x) { f32x4 r; r.x = prefix16(x.x); r.y = prefix16(x.y); r.z = prefix16(x.z); r.w = prefix16(x.w); return r; }
__device__ __forceinline__ f32x4 bcast15v(f32x4 x) { f32x4 r; r.x = dppf<0x15f>(x.x); r.y = dppf<0x15f>(x.y); r.z = dppf<0x15f>(x.z); r.w = dppf<0x15f>(x.w); return r; }
__device__ __forceinline__ f32x4 expv(f32x4 x) { f32x4 r; r.x = __expf(x.x); r.y = __expf(x.y); r.z = __expf(x.z); r.w = __expf(x.w); return r; }

struct ChunkPrep { bf16x8 KtF0; bf16x4 AkkP; bf16x8 KtF1; bf16x4 N8; bf16x8 RtF0; bf16x4 N4; bf16x8 RtF1; bf16x4 N2; bf16x8 ARp; bf16x4 Nn; };
struct ChunkCtx { const float *R, *Kb, *V, *Wd, *A, *INVN, *kk, *ka; float* Y; int rfirst, rstep, h, fr, fq, chb; };
struct ChunkConst { const LAS float* tab; };
template <int NVT> struct ChunkRaw { f32x4 k[4], r[4], a[4], w[4]; f32x4 v[NVT]; float nv; };
template <int NVT> __device__ __forceinline__ void chunk_load(const ChunkCtx& C, int c0, int vt0, ChunkRaw<NVT>& W) {
    const int fr = C.fr, fq = C.fq;
    const size_t rrow = (size_t)(C.rfirst + C.rstep * (c0 + fr));
    const size_t rt = rrow * CW + C.chb;
    W.nv = C.INVN[rrow * 16 + C.h];
#pragma unroll
    for (int q = 0; q < 4; ++q) { const int co = 16 * q;
        W.k[q] = *(const f32x4*)(C.Kb + rt + co); W.r[q] = *(const f32x4*)(C.R + rt + co); W.a[q] = *(const f32x4*)(C.A + rt + co); W.w[q] = *(const f32x4*)(C.Wd + rt + co); }
#pragma unroll
    for (int j = 0; j < 4; ++j) { const size_t ri = (size_t)(C.rfirst + C.rstep * (c0 + 4 * fq + j)) * CW + C.h * 64 + fr;
#pragma unroll
        for (int vi = 0; vi < NVT; ++vi) W.v[vi][j] = C.V[ri + 16 * (vt0 + vi)]; }
}
constexpr int RING_SLOT = 17664;
template <int NVT> __device__ __forceinline__ void chunk_dma(const ChunkCtx& C, int c0, int vt0, LAS unsigned char* slot) {
    const int fr = C.fr, fq = C.fq;
    const size_t rrow = (size_t)(C.rfirst + C.rstep * (c0 + fr));
    const size_t rt = rrow * CW + C.chb;
#pragma unroll
    for (int q = 0; q < 4; ++q) {
        __builtin_amdgcn_global_load_lds((const unsigned*)(C.Kb + rt + 16 * q), (LAS unsigned*)(slot + (0 + q) * 1024), 16, 0, 0);
        __builtin_amdgcn_global_load_lds((const unsigned*)(C.R + rt + 16 * q), (LAS unsigned*)(slot + (4 + q) * 1024), 16, 0, 0);
        __builtin_amdgcn_global_load_lds((const unsigned*)(C.A + rt + 16 * q), (LAS unsigned*)(slot + (8 + q) * 1024), 16, 0, 0);
        __builtin_amdgcn_global_load_lds((const unsigned*)(C.Wd + rt + 16 * q), (LAS unsigned*)(slot + (12 + q) * 1024), 16, 0, 0);
    }
#pragma unroll
    for (int j = 0; j < 4; ++j) { const size_t ri = (size_t)(C.rfirst + C.rstep * (c0 + 4 * fq + j)) * CW + C.h * 64 + fr + 16 * vt0;
#pragma unroll
        for (int vi = 0; vi < NVT; ++vi) __builtin_amdgcn_global_load_lds((const unsigned*)(C.V + ri + 16 * vi), (LAS unsigned*)(slot + 16384 + (vi * 4 + j) * 256), 4, 0, 0); }
    __builtin_amdgcn_global_load_lds((const unsigned*)(C.INVN + rrow * 16 + C.h), (LAS unsigned*)(slot + 16384 + NVT * 1024), 4, 0, 0);
}
__device__ __forceinline__ void chunk_unpark(const LAS unsigned char* slot, int lane, ChunkRaw<1>& W) {
#pragma unroll
    for (int q = 0; q < 4; ++q) {
        W.k[q] = *(const LAS f32x4*)(slot + (0 + q) * 1024 + lane * 16); W.r[q] = *(const LAS f32x4*)(slot + (4 + q) * 1024 + lane * 16);
        W.a[q] = *(const LAS f32x4*)(slot + (8 + q) * 1024 + lane * 16); W.w[q] = *(const LAS f32x4*)(slot + (12 + q) * 1024 + lane * 16); }
#pragma unroll
    for (int j = 0; j < 4; ++j) W.v[0][j] = *(const LAS float*)(slot + 16384 + j * 256 + lane * 4);
    W.nv = *(const LAS float*)(slot + 16384 + 1024 + lane * 4);
}
template <int NVT, int SRC> __device__ __forceinline__ void chunk_prep(const ChunkCtx& C, const ChunkConst& K, const ChunkRaw<NVT>& W, const LAS unsigned char* slot, int c0, int vt0, LAS bf16_t* TK, LAS float* FD, ChunkPrep& P, bf16x4 (&Vp)[NVT]) {
    constexpr bool RAW = (SRC == 1);
    LAS bf16_t* TB = TK + 1024;
    const int fr = C.fr, fq = C.fq, F_lane = 16 * C.fq + C.fr;
    const size_t rrow = (size_t)(C.rfirst + C.rstep * (c0 + fr));
    const size_t rt = rrow * CW + C.chb;
    float nv; if constexpr (SRC == 1) nv = W.nv; else if constexpr (SRC == 2) nv = *(const LAS float*)(slot + 16384 + NVT * 1024 + F_lane * 4); else nv = C.INVN[rrow * 16 + C.h];
    bf16x8 KhF[2], BhF[2], KtFl[2], RtFl[2];
#pragma unroll
    for (int ks = 0; ks < 2; ++ks) {
        f32x4 Kt[2], Kh[2], Bh[2], Rt[2];
#pragma unroll
        for (int hh = 0; hh < 2; ++hh) {
            const int co = 32 * ks + 16 * hh;
            f32x4 kx, rx, ax, wx;
            if constexpr (SRC == 1) { kx = W.k[2 * ks + hh]; rx = W.r[2 * ks + hh]; ax = W.a[2 * ks + hh]; wx = W.w[2 * ks + hh]; }
            else if constexpr (SRC == 2) { const int q = 2 * ks + hh; kx = *(const LAS f32x4*)(slot + (0 + q) * 1024 + F_lane * 16); rx = *(const LAS f32x4*)(slot + (4 + q) * 1024 + F_lane * 16);
                ax = *(const LAS f32x4*)(slot + (8 + q) * 1024 + F_lane * 16); wx = *(const LAS f32x4*)(slot + (12 + q) * 1024 + F_lane * 16); }
            else { kx = *(const f32x4*)(C.Kb + rt + co); rx = *(const f32x4*)(C.R + rt + co); ax = *(const f32x4*)(C.A + rt + co); wx = *(const f32x4*)(C.Wd + rt + co); }
            f32x4 kkc, kac;
            if constexpr (SRC != 0) { kkc = *(const LAS f32x4*)(K.tab + fq * 32 + 4 * (2 * ks + hh)); kac = *(const LAS f32x4*)(K.tab + fq * 32 + 16 + 4 * (2 * ks + hh)); } else { kkc = *(const f32x4*)(C.kk + C.chb + co); kac = *(const f32x4*)(C.ka + C.chb + co); }
            const f32x4 kap = kx * kkc * nv, bet = kap * ax, kbar = kx + kx * (ax - 1.0f) * kac;
            f32x4 e1, e2, e0;
#pragma unroll
            for (int j = 0; j < 4; ++j) { e1[j] = __builtin_amdgcn_exp2f(-wx[j]); e2[j] = __builtin_amdgcn_exp2f(wx[j]); }
            e0 = dppv<0x111>(e1);
            if (fr == 0) e0 = (f32x4){1.f, 1.f, 1.f, 1.f};
            Kt[hh] = kap * e0; Kh[hh] = kbar * e2; Bh[hh] = bet * e2; Rt[hh] = rx * e1;
            *(LAS f32x4*)(fr == 15 ? FD + fq * 16 + 8 * ks + 4 * hh : FD + 64) = e1;
            { const int cs = ((((co >> 2) + fq) ^ fr) << 2);
              *(LAS bf16x4*)(TK + fr * 64 + cs) = pack4(Kh[hh]); *(LAS bf16x4*)(TB + fr * 64 + cs) = pack4(Bh[hh]); }
        }
        KtFl[ks] = pack8(Kt[0], Kt[1]); KhF[ks] = pack8(Kh[0], Kh[1]); BhF[ks] = pack8(Bh[0], Bh[1]); RtFl[ks] = pack8(Rt[0], Rt[1]);
    }
    const f32x4 z4 = (f32x4){0.f, 0.f, 0.f, 0.f};
    f32x4 AkkL1 = z4, AkbL1 = z4, AkbL2 = z4, ArkL1 = z4, ArbL1 = z4;
#pragma unroll
    for (int ks = 0; ks < 2; ++ks) {
        AkkL1 = MFMA16(KhF[ks], KtFl[ks], AkkL1); AkbL1 = MFMA16(BhF[ks], KtFl[ks], AkbL1); AkbL2 = MFMA16(KtFl[ks], BhF[ks], AkbL2);
        ArkL1 = MFMA16(KhF[ks], RtFl[ks], ArkL1); ArbL1 = MFMA16(BhF[ks], RtFl[ks], ArbL1);
    }
    P.KtF0 = KtFl[0]; P.KtF1 = KtFl[1]; P.RtF0 = RtFl[0]; P.RtF1 = RtFl[1];
#pragma unroll
    for (int j = 0; j < 4; ++j) { const int ci = 4 * fq + j;
        if (!(ci < fr)) { AkkL1[j] = 0.f; AkbL1[j] = 0.f; }
        if (!(fr < ci)) AkbL2[j] = 0.f;
        if (!(ci <= fr)) { ArkL1[j] = 0.f; ArbL1[j] = 0.f; } }
    P.AkkP = pack4(AkkL1); P.ARp = cat44(pack4(ArkL1), pack4(ArbL1));
    const bf16x4 N1L1 = pack4(AkbL1), N1L2 = pack4(AkbL2);
    const f32x4 N2L2f = MFMA16K(N1L1, N1L2, z4), N2L1f = MFMA16K(N1L2, N1L1, z4);
    const bf16x4 N2L1 = pack4(N2L1f), N2L2 = pack4(N2L2f);
    const f32x4 N4L2f = MFMA16K(N2L1, N2L2, z4), N4L1f = MFMA16K(N2L2, N2L1, z4);
    const bf16x4 N4L1 = pack4(N4L1f), N4L2 = pack4(N4L2f);
    P.N8 = pack4(MFMA16K(N4L2, N4L1, z4)); P.N4 = N4L1; P.N2 = N2L1; P.Nn = pack4(-AkbL1);
#pragma unroll
    for (int vi = 0; vi < NVT; ++vi) {
        if constexpr (SRC == 1) Vp[vi] = pack4(W.v[vi]);
        else if constexpr (SRC == 2) { f32x4 t4;
#pragma unroll
            for (int j = 0; j < 4; ++j) t4[j] = *(const LAS float*)(slot + 16384 + (vi * 4 + j) * 256 + F_lane * 4);
            Vp[vi] = pack4(t4); }
        else { f32x4 t4;
#pragma unroll
            for (int j = 0; j < 4; ++j) t4[j] = C.V[(size_t)(C.rfirst + C.rstep * (c0 + 4 * fq + j)) * CW + C.h * 64 + fr + 16 * (vt0 + vi)];
            Vp[vi] = pack4(t4); }
    }
}
template <int NVT, bool DEFER = false> __device__ __forceinline__ void chunk_chain(const ChunkCtx& C, int c0, int vt0, const LAS bf16_t* TK, const LAS float* FD, const ChunkPrep& P, const bf16x4 (&Vp)[NVT], f32x4 (&Sacc)[4][NVT], f32x4* ydef = nullptr) {
    const LAS bf16_t* TB = TK + 1024;
    const int fr = C.fr, fq = C.fq;
    const f32x4 z4 = (f32x4){0.f, 0.f, 0.f, 0.f};
    size_t rowi[4];
#pragma unroll
    for (int j = 0; j < 4; ++j) rowi[j] = (size_t)(C.rfirst + C.rstep * (c0 + 4 * fq + j)) * CW + C.h * 64 + fr;
    bf16x8 VW[NVT];
#pragma unroll
    for (int vi = 0; vi < NVT; ++vi) {
        const bf16x8 s0 = pack8(Sacc[0][vi], Sacc[1][vi]), s1 = pack8(Sacc[2][vi], Sacc[3][vi]);
        f32x4 x = z4; x = MFMA16(P.KtF0, s0, x); x = MFMA16(P.KtF1, s1, x); x = MFMA16K(P.AkkP, Vp[vi], x); x = -x;
        f32x4 y = z4; y = MFMA16(P.RtF0, s0, y); y = MFMA16(P.RtF1, s1, y);
        x = MFMA16K(P.N8, pack4(x), x); x = MFMA16K(P.N4, pack4(x), x); x = MFMA16K(P.N2, pack4(x), x); x = MFMA16K(P.Nn, pack4(x), x);
        VW[vi] = cat44(Vp[vi], pack4(x));
        y = MFMA16(P.ARp, VW[vi], y);
        const int vo = 16 * (vt0 + vi);
        if constexpr (DEFER) ydef[vi] = y;
        else { C.Y[rowi[0] + vo] = y.x; C.Y[rowi[1] + vo] = y.y; C.Y[rowi[2] + vo] = y.z; C.Y[rowi[3] + vo] = y.w; }
    }
#pragma unroll
    for (int kt = 0; kt < 4; ++kt) {
        const int trow = 4 * fq + (fr >> 2), tcs = (((4 * kt + (fr & 3)) ^ trow) << 2);
        const bf16x4 pk_ = __builtin_amdgcn_ds_read_tr16_b64_v4i16((LAS bf16x4*)(TK + trow * 64 + tcs)), pb_ = __builtin_amdgcn_ds_read_tr16_b64_v4i16((LAS bf16x4*)(TB + trow * 64 + tcs));
        const bf16x8 SUP = cat44(pk_, pb_);
        const f32x4 fd = *(const LAS f32x4*)(FD + fq * 16 + 4 * kt);
#pragma unroll
        for (int vi = 0; vi < NVT; ++vi) Sacc[kt][vi] = MFMA16(SUP, VW[vi], Sacc[kt][vi]) * fd;
    }
}
template <int NVT, int MODE> __device__ __forceinline__ void scan_chunk_job(const Frame& F, CParams p, int l, int chain, int vt0, bool lat, LAS unsigned char* wbase) {
    unsigned char* ws = p->ws;
    const int b = chain >> 5, h = (chain & 31) >> 1, dir = chain & 1;
    const int L = lat ? 1024 : 256, base = lat ? MC + b * 1024 : b * 256;
    ChunkCtx C;
    C.fr = F.lane & 15; C.fq = F.lane >> 4; C.h = h; C.chb = h * 64 + 4 * C.fq;
    C.R = (const float*)(ws + WS_SC); C.Kb = C.R + (size_t)M * CW; C.V = C.Kb + (size_t)M * CW;
    C.Wd = C.R + (size_t)(3 + dir) * M * CW; C.A = C.R + (size_t)(5 + dir) * M * CW;
    C.INVN = (const float*)(ws + WS_INVN);
    C.Y = (float*)(ws + WS_Z) + (size_t)dir * M * CW;
    C.kk = p->k_k + l * CW; C.ka = p->k_a + l * CW;
    C.rstep = dir ? -1 : 1; C.rfirst = dir ? base + L - 1 : base;
    const size_t srow = (size_t)(((b * 2 + l) * 2 + dir) * 16 + h) * 4096;
    const int fr = C.fr, fq = C.fq;
    f32x4 Sacc[4][NVT];
    if (lat) {
        const float* s0 = p->state_wkv + srow;
#pragma unroll
        for (int kt = 0; kt < 4; ++kt)
#pragma unroll
            for (int vi = 0; vi < NVT; ++vi) Sacc[kt][vi] = *(const f32x4*)(s0 + (16 * (vt0 + vi) + fr) * 64 + 16 * kt + 4 * fq);
    } else {
#pragma unroll
        for (int kt = 0; kt < 4; ++kt)
#pragma unroll
            for (int vi = 0; vi < NVT; ++vi) Sacc[kt][vi] = (f32x4){0.f, 0.f, 0.f, 0.f};
    }
    ChunkConst KC; KC.tab = (const LAS float*)(F.lds + LDS_MISC + 1024 + F.wave * 512);
    if (MODE != 0) {
        LAS float* tw = (LAS float*)(F.lds + LDS_MISC + 1024 + F.wave * 512) + fq * 32;
        if (fr == 0) {
#pragma unroll
            for (int q = 0; q < 4; ++q) { *(LAS f32x4*)(tw + 4 * q) = *(const f32x4*)(C.kk + C.chb + 16 * q); *(LAS f32x4*)(tw + 16 + 4 * q) = *(const f32x4*)(C.ka + C.chb + 16 * q); }
        }
    }
    if (lat) __builtin_amdgcn_s_setprio(LAT_PRIO);
    ChunkRaw<NVT> Rw;
    if constexpr (MODE == 1) {
        LAS bf16_t* T0 = (LAS bf16_t*)wbase; LAS float* FD0 = (LAS float*)(wbase + 8192); LAS unsigned char* ring = wbase + 9216;
        ChunkPrep P; bf16x4 Vp[NVT];
        chunk_dma<NVT>(C, 0, vt0, ring);
        asm volatile("s_waitcnt vmcnt(0)" ::: "memory");
        chunk_unpark(ring, F.lane, Rw);
        asm volatile("s_waitcnt lgkmcnt(0)" ::: "memory");
        chunk_dma<NVT>(C, 16, vt0, ring);
        chunk_prep<NVT, 1>(C, KC, Rw, ring, 0, vt0, T0, FD0, P, Vp);
#pragma unroll 1
        for (int c0 = 0; c0 < L; c0 += 16) {
            const int par = (c0 >> 4) & 1, cn = (c0 + 32 < L) ? c0 + 32 : L - 16;
            f32x4 yv[NVT];
            chunk_chain<NVT, true>(C, c0, vt0, T0 + par * 2048, FD0 + par * 80, P, Vp, Sacc, yv);
            __builtin_amdgcn_sched_barrier(0);
            asm volatile("s_waitcnt vmcnt(0)" ::: "memory");
            chunk_unpark(ring, F.lane, Rw);
            asm volatile("s_waitcnt lgkmcnt(0)" ::: "memory");
#pragma unroll
            for (int vi = 0; vi < NVT; ++vi) {
#pragma unroll
                for (int j = 0; j < 4; ++j) C.Y[(size_t)(C.rfirst + C.rstep * (c0 + 4 * fq + j)) * CW + C.h * 64 + fr + 16 * (vt0 + vi)] = yv[vi][j];
            }
            chunk_dma<NVT>(C, cn, vt0, ring);
#ifdef DBG_DMA2
            __builtin_amdgcn_sched_barrier(0);
            chunk_dma<NVT>(C, cn, vt0, ring);
#endif
            __builtin_amdgcn_sched_barrier(0);
            ChunkPrep Pn; bf16x4 Vn[NVT];
            chunk_prep<NVT, 1>(C, KC, Rw, ring, c0 + 16, vt0, T0 + (par ^ 1) * 2048, FD0 + (par ^ 1) * 80, Pn, Vn);
            __builtin_amdgcn_sched_barrier(0);
            P = Pn;
#pragma unroll
            for (int vi = 0; vi < NVT; ++vi) Vp[vi] = Vn[vi];
        }
    } else if constexpr (MODE == 2) {
        LAS bf16_t* T0 = (LAS bf16_t*)wbase; LAS float* FD0 = (LAS float*)(wbase + 4096); LAS unsigned char* ring = wbase + 4608;
        chunk_dma<NVT>(C, 0, vt0, ring);
        f32x4 yv[NVT]; bool havey = false;
#pragma unroll 1
        for (int c0 = 0; c0 < L; c0 += 16) {
            const int cn = (c0 + 16 < L) ? c0 + 16 : c0;
            asm volatile("s_waitcnt vmcnt(0)" ::: "memory");
            ChunkPrep P; bf16x4 Vp[NVT];
            chunk_prep<NVT, 2>(C, KC, Rw, ring, c0, vt0, T0, FD0, P, Vp);
            asm volatile("s_waitcnt lgkmcnt(0)" ::: "memory");
            __builtin_amdgcn_sched_barrier(0);
            if (havey) {
#pragma unroll
                for (int vi = 0; vi < NVT; ++vi) {
#pragma unroll
                    for (int j = 0; j < 4; ++j) C.Y[(size_t)(C.rfirst + C.rstep * (c0 - 16 + 4 * fq + j)) * CW + C.h * 64 + fr + 16 * (vt0 + vi)] = yv[vi][j];
                }
            }
            chunk_dma<NVT>(C, cn, vt0, ring);
            __builtin_amdgcn_sched_barrier(0);
            chunk_chain<NVT, true>(C, c0, vt0, T0, FD0, P, Vp, Sacc, yv);
            havey = true;
        }
        asm volatile("s_waitcnt vmcnt(0)" ::: "memory");
#pragma unroll
        for (int vi = 0; vi < NVT; ++vi) {
#pragma unroll
            for (int j = 0; j < 4; ++j) C.Y[(size_t)(C.rfirst + C.rstep * (L - 16 + 4 * fq + j)) * CW + C.h * 64 + fr + 16 * (vt0 + vi)] = yv[vi][j];
        }
    } else {
        LAS bf16_t* T0 = (LAS bf16_t*)wbase; LAS float* FD0 = (LAS float*)(wbase + 4096);
#pragma unroll 1
        for (int c0 = 0; c0 < L; c0 += 16) {
            ChunkPrep P; bf16x4 Vp[NVT];
            chunk_prep<NVT, 0>(C, KC, Rw, wbase, c0, vt0, T0, FD0, P, Vp);
            chunk_chain<NVT>(C, c0, vt0, T0, FD0, P, Vp, Sacc);
        }
    }
    __builtin_amdgcn_s_setprio(0);
    if (!lat) {
        float* so = p->out + (size_t)M * D + srow;
#pragma unroll
        for (int kt = 0; kt < 4; ++kt)
#pragma unroll
            for (int vi = 0; vi < NVT; ++vi) *(f32x4*)(so + (16 * (vt0 + vi) + fr) * 64 + 16 * kt + 4 * fq) = Sacc[kt][vi];
    }
}
__device__ __forceinline__ void seqmix_phase(const Frame& F, CParams p, int l, int rep, int part = 3) {
    unsigned* ctr = (unsigned*)(p->ws + WS_CTL) + CW_JOB + 64 * (l + 2 * rep);
#if SCAN_CHUNKED
    constexpr int J_SCAN = 512 + 1024, J_FL = J_SCAN + 512, J_FC = J_FL + 1024, NJ = J_FC + 1536;
    const bool static_all = (F.G == 256);
    if (part & 1) {
        if (static_all) {
            if (F.wave < 2) { const int q = 2 * F.bid + F.wave; scan_chunk_job<1, 1>(F, p, l, q >> 2, q & 3, true, F.lds + F.wave * 26880); }
            else if (F.wave < 6) scan_chunk_job<4, 2>(F, p, l, 4 * F.bid + (F.wave - 2), 0, false, F.lds + 53760 + (F.wave - 2) * 25344);
        }
    }
    if (!(part & 2)) return;
    for (int rq = 0; rq < DBG_DUP_Q; ++rq)
    for (;;) {
        unsigned j = 0;
        if (F.lane == 0) j = __hip_atomic_fetch_add(ctr + 128 * rq, 1u, __ATOMIC_RELAXED, __HIP_MEMORY_SCOPE_AGENT);
        const int job = (int)__builtin_amdgcn_readfirstlane(j) + (static_all ? J_SCAN : 0);
        if (job >= NJ) break;
        if (job < 512) scan_chunk_job<1, 0>(F, p, l, job >> 2, job & 3, true, F.lds + F.wave * 8192);
        else if (job < J_SCAN) scan_chunk_job<4, 0>(F, p, l, job - 512, 0, false, F.lds + F.wave * 8192);
#else
    constexpr int J_SCAN = 512 + 4096, J_FL = J_SCAN + 512, J_FC = J_FL + 1024, NJ = J_FC + 1536;
    const bool static_lat = (F.G == 256);
    if (static_lat && F.wave < 2) scan_job(F, p, l, 2 * F.bid + F.wave);
    for (;;) {
        unsigned j = 0;
        if (F.lane == 0) j = __hip_atomic_fetch_add(ctr, 1u, __ATOMIC_RELAXED, __HIP_MEMORY_SCOPE_AGENT);
        const int job = (int)__builtin_amdgcn_readfirstlane(j) + (static_lat ? 512 : 0);
        if (job >= NJ) break;
        if (job < J_SCAN) scan_job(F, p, l, job);
#endif
        else if (job < J_FL) { if (rq == 0 || (DBG_DUP_SEL & 2)) fnet_seq_job(F, p, job - J_SCAN, true); }
        else if (job < J_FC) { if (rq == 0 || (DBG_DUP_SEL & 4)) fnet_seq_job(F, p, job - J_FL, false); }
        else { if (rq == 0 || (DBG_DUP_SEL & 8)) sgu_job(F, p, l, job - J_FC); }
    }
}

__device__ __forceinline__ void post_phase(const Frame& F, CParams p, int l) {
    unsigned char* ws = p->ws;
#if FNET_IN_POST
    {
        unsigned* ctr = (unsigned*)(ws + WS_CTL) + CW_JOB + 64 * (8 + l);
        for (;;) {
            unsigned j = 0;
            if (F.lane == 0) j = __hip_atomic_fetch_add(ctr, 1u, __ATOMIC_RELAXED, __HIP_MEMORY_SCOPE_AGENT);
            const int job = (int)__builtin_amdgcn_readfirstlane(j);
            if (job >= 512 + 1024 + 1536) break;
            if (job < 512) fnet_seq_job(F, p, job, true);
            else if (job < 1536) fnet_seq_job(F, p, job - 512, false);
            else sgu_job(F, p, l, job - 1536);
        }
    }
#endif
    const float* R = (const float*)(ws + WS_SC); const float* Kb = R + (size_t)M * CW; const float* V = Kb + (size_t)M * CW;
    const float* A0 = R + (size_t)5 * M * CW; const float* A1 = R + (size_t)6 * M * CW;
    const float* Y0 = (const float*)(ws + WS_Z); const float* Y1 = Y0 + (size_t)M * CW;
    const bf16_t* G = (const bf16_t*)(ws + WS_G); bf16_t* MIX = (bf16_t*)(ws + WS_H);
    const int gw = F.bid * NWAVES + F.wave, NGW = F.G * NWAVES;
    for (int row = gw; row < M; row += NGW) {
#pragma unroll
        for (int i = 0; i < 4; ++i) {
            const int ch = 4 * F.lane + 256 * i; const size_t o = (size_t)row * CW + ch;
            const f32x4 y = *(const f32x4*)(Y0 + o) + *(const f32x4*)(Y1 + o);
            const float mu = sum16((y.x + y.y) + (y.z + y.w)) * (1.0f / 64.0f);
            const f32x4 d = y - mu;
            const float var = sum16((d.x * d.x + d.y * d.y) + (d.z * d.z + d.w * d.w)) * (1.0f / 64.0f);
            const float rs = __builtin_amdgcn_rsqf(var + 64e-5f);
            const f32x4 yn = d * rs * *(const f32x4*)(p->lnx_g + l * CW + ch) + *(const f32x4*)(p->lnx_b + l * CW + ch);
            const f32x4 k = *(const f32x4*)(Kb + o), a0 = *(const f32x4*)(A0 + o), a1 = *(const f32x4*)(A1 + o), r = *(const f32x4*)(R + o), v = *(const f32x4*)(V + o);
            const f32x4 ka = *(const f32x4*)(p->k_a + l * CW + ch), rk = *(const f32x4*)(p->r_k + l * CW + ch);
            const f32x4 km = k * (2.0f + (a0 + a1 - 2.0f) * ka);
            const f32x4 tb = r * km * rk;
            const float bonus = sum16((tb.x + tb.y) + (tb.z + tb.w));
            const u32x2 gg = *(const u32x2*)(G + o);
            const float g0 = __uint_as_float(gg.x << 16), g1 = __uint_as_float(gg.x & 0xffff0000u), g2 = __uint_as_float(gg.y << 16), g3 = __uint_as_float(gg.y & 0xffff0000u);
            const f32x4 ov = yn + v * bonus;
            u32x2 w; w.x = pk2(ov.x * g0, ov.y * g1); w.y = pk2(ov.z * g2, ov.w * g3);
            *(u32x2*)(MIX + pg8::blk_off(row, 1024 + ch, D)) = w;
        }
    }
}

constexpr int NPHASE = 26;
__global__ void __launch_bounds__(NTHR, 2) fwd(Params p) {
    extern __shared__ __attribute__((aligned(16))) unsigned char lds_raw[];
    Frame F;
    F.lds = (LAS unsigned char*)lds_raw;
    F.tid = threadIdx.x; F.lane = F.tid & 63; F.wave = __builtin_amdgcn_readfirstlane(F.tid >> 6);
    F.G = gridDim.x; F.bid = blockIdx.x;
    unsigned char* const ws = p.ws;
    if (F.tid < 256) ((LAS unsigned*)(F.lds + LDS_MISC))[F.tid] = 0u;
    __syncthreads();
#if ONE_LAUNCH
    XcdBarrier bar = xcd_barrier_post((unsigned*)(ws + WS_CTL) + CW_BAR, (volatile LAS unsigned*)(F.lds + LDS_MISC));
#define SEAM(k) do { if (IN((k) + 1)) xcd_barrier(bar); } while (0)
#else
#define SEAM(k) do { } while (0)
#endif
    const int lo = p.ph_lo, hi = p.ph_hi;
#ifndef PH_MASK
#define PH_MASK 0x3fff
#endif
#define EN(i) ((PH_MASK >> (i)) & 1)
#define IN(k) (lo <= (k) && (k) < hi)
#define INL(j) (EN(1 + (j)) && IN(pb + (j)))
#ifndef REP_MASK
#define REP_MASK 0
#endif
#define NREP(j) (1 + ((REP_MASK >> (j)) & 1))
    const bf16_t* H = (const bf16_t*)(ws + WS_H);
    bf16_t* X = (bf16_t*)(ws + WS_X);

    if (EN(0) && IN(0)) for (int rep = 0; rep < NREP(15); ++rep) { p0_prologue(fresh(F), get_params()); SEAM(0); }

    for (int l = 0; l < 2; ++l) {
        const int pb = 1 + 12 * l;
        const float* modf = (const float*)(ws + WS_MODF) + (size_t)l * 5 * NMOD;
        if (INL(0)) for (int rep = 0; rep < NREP(0); ++rep) { if (l == 0) norm_phase<true>(fresh(F), get_params(), l, 0, get_params()->x_prompt, get_params()->x_sample); else norm_phase<false>(fresh(F), get_params(), l, 0, X, X + (size_t)MC * D); SEAM(pb + 0); }
        if (INL(1)) for (int rep = 0; rep < NREP(1); ++rep) {
            pg8::Gemm g{H, (const bf16_t*)(ws + WS_WFFI) + (size_t)(l * 2 + 0) * NFF * D, M, NFF, D}; pg8::SplitOrder<false> S; S.init(M, NFF, F.G, F.bid);
            pg8::EpiSwiGLU<4> E{(bf16_t*)(ws + WS_Z), DFF};
            pg8::gemm_phase<pg8::EpiSwiGLU<4>, pg8::SplitOrder<false>, GEMM_ALIGN, GEMM_SP2>(F.lds, g, S, E);
            pg8::SplitOrder<true> S2; S2.init(M, NFF, F.G, F.bid);
            pg8::EpiSwiGLU<2> E2{(bf16_t*)(ws + WS_Z), DFF};
            pg8::gemm_phase<pg8::EpiSwiGLU<2>, pg8::SplitOrder<true>, GEMM_ALIGN, GEMM_SP2, 2>(F.lds, g, S2, E2);
            SEAM(pb + 1);
        }
        if (INL(2)) {
            pg8::Gemm g{(const bf16_t*)(ws + WS_Z), (const bf16_t*)(ws + WS_WFFO) + (size_t)(l * 2 + 0) * D * DFF, M, D, DFF}; pg8::StaticOrder S; S.init(M / 192 * 256, D, F.G, F.bid);
            if (l == 0) { pg8::EpiResid<3, true> E{get_params()->x_prompt, get_params()->x_sample, X, modf, 2, 0.5f};
                pg8::gemm_phase<pg8::EpiResid<3, true>, pg8::StaticOrder, GEMM_ALIGN, GEMM_SP2, 3>(F.lds, g, S, E); }
            else { pg8::EpiResid<3, false> E{X, X + (size_t)MC * D, X, modf, 2, 0.5f};
                pg8::gemm_phase<pg8::EpiResid<3, false>, pg8::StaticOrder, GEMM_ALIGN, GEMM_SP2, 3>(F.lds, g, S, E); }
            SEAM(pb + 2);
        }
        if (INL(3)) for (int rep = 0; rep < NREP(3); ++rep) { norm_phase<false>(fresh(F), get_params(), l, 1, X, X + (size_t)MC * D); SEAM(pb + 3); }
        if (INL(4)) for (int rep = 0; rep < NREP(4); ++rep) {
            pg8::Gemm g{H, (const bf16_t*)(ws + WS_WIN) + (size_t)l * NINP * D, M, NINP, D}; pg8::SplitOrder<false> S; S.init(M, NINP, F.G, F.bid);
            pg8::EpiBf16<4> E{(bf16_t*)(ws + WS_Z), NINP};
            pg8::gemm_phase<pg8::EpiBf16<4>, pg8::SplitOrder<false>, GEMM_ALIGN, GEMM_SP2>(F.lds, g, S, E);
            pg8::SplitOrder<true> S2; S2.init(M, NINP, F.G, F.bid);
            pg8::EpiBf16<2> E2{(bf16_t*)(ws + WS_Z), NINP};
            pg8::gemm_phase<pg8::EpiBf16<2>, pg8::SplitOrder<true>, GEMM_ALIGN, GEMM_SP2, 2>(F.lds, g, S2, E2);
            SEAM(pb + 4);
        }
        if (INL(5)) for (int rep = 0; rep < NREP(5); ++rep) { mixprep_phase(fresh(F), get_params(), l); SEAM(pb + 5); }
#if defined(DBG_SPLIT)
        if (INL(6)) { for (int r2 = 0; r2 < DBG_SPLIT; ++r2) { seqmix_phase(fresh(F), get_params(), l, 0, 1); xcd_barrier(bar); }
                      for (int r3 = 0; r3 < DBG_SPLITQ; ++r3) { seqmix_phase(fresh(F), get_params(), l, r3, 2); SEAM(pb + 6); } }
#else
        if (INL(6)) for (int rep = 0; rep < NREP(6); ++rep) { seqmix_phase(fresh(F), get_params(), l, rep); SEAM(pb + 6); }
#endif
        if (INL(7)) for (int rep = 0; rep < NREP(7); ++rep) { post_phase(fresh(F), get_params(), l); SEAM(pb + 7); }
        if (INL(8)) {
            pg8::Gemm g{H, (const bf16_t*)(ws + WS_WOUT) + (size_t)l * D * D, M, D, D}; pg8::StaticOrder S; S.init(M / 192 * 256, D, F.G, F.bid);
            pg8::EpiResid<3, false> E{X, X + (size_t)MC * D, X, modf, 5, 1.0f};
            pg8::gemm_phase<pg8::EpiResid<3, false>, pg8::StaticOrder, GEMM_ALIGN, GEMM_SP2, 3>(F.lds, g, S, E);
            SEAM(pb + 8);
        }
        if (INL(9)) for (int rep = 0; rep < NREP(9); ++rep) { norm_phase<false>(fresh(F), get_params(), l, 2, X, X + (size_t)MC * D); SEAM(pb + 9); }
        if (INL(10)) {
            pg8::Gemm g{H, (const bf16_t*)(ws + WS_WFFI) + (size_t)(l * 2 + 1) * NFF * D, M, NFF, D}; pg8::SplitOrder<false> S; S.init(M, NFF, F.G, F.bid);
            pg8::EpiSwiGLU<4> E{(bf16_t*)(ws + WS_Z), DFF};
            pg8::gemm_phase<pg8::EpiSwiGLU<4>, pg8::SplitOrder<false>, GEMM_ALIGN, GEMM_SP2>(F.lds, g, S, E);
            pg8::SplitOrder<true> S2; S2.init(M, NFF, F.G, F.bid);
            pg8::EpiSwiGLU<2> E2{(bf16_t*)(ws + WS_Z), DFF};
            pg8::gemm_phase<pg8::EpiSwiGLU<2>, pg8::SplitOrder<true>, GEMM_ALIGN, GEMM_SP2, 2>(F.lds, g, S2, E2);
            SEAM(pb + 10);
        }
        if (INL(11)) {
            pg8::Gemm g{(const bf16_t*)(ws + WS_Z), (const bf16_t*)(ws + WS_WFFO) + (size_t)(l * 2 + 1) * D * DFF, M, D, DFF}; pg8::StaticOrder S; S.init(M / 192 * 256, D, F.G, F.bid);
            pg8::EpiResid<3, false> E{X, X + (size_t)MC * D, X, modf, 8, 0.5f};
            pg8::gemm_phase<pg8::EpiResid<3, false>, pg8::StaticOrder, GEMM_ALIGN, GEMM_SP2, 3>(F.lds, g, S, E);
            SEAM(pb + 11);
        }
    }
    if (EN(13) && IN(25)) final_phase(fresh(F), get_params());
#undef IN
#undef INL
#undef NREP
#undef EN
#undef SEAM
}

extern "C" void kernel_launch(void* const* d_in, const int* in_sizes, int n_in, void* d_out, int out_size, void* d_ws, size_t ws_size, hipStream_t stream) {
    static int grid = 0;
    if (grid == 0) {
        if (n_in != 28 || ws_size < WS_END) { fprintf(stderr, "kernel_launch: expected 28 inputs and >= %zu bytes of workspace (got %d, %zu)\n", (size_t)WS_END, n_in, ws_size); grid = -1; return; }
        int dev = 0, cus = 0, per_cu = 0;
        if (hipGetDevice(&dev) != hipSuccess || hipDeviceGetAttribute(&cus, hipDeviceAttributeMultiprocessorCount, dev) != hipSuccess) { grid = -1; return; }
        if (hipFuncSetAttribute((const void*)fwd, hipFuncAttributeMaxDynamicSharedMemorySize, LDS_BYTES) != hipSuccess) { fprintf(stderr, "kernel_launch: hipFuncSetAttribute failed\n"); grid = -1; return; }
        if (hipOccupancyMaxActiveBlocksPerMultiprocessor(&per_cu, (const void*)fwd, NTHR, LDS_BYTES) != hipSuccess || per_cu < 1)
            fprintf(stderr, "kernel_launch: occupancy query reports %d workgroups per CU\n", per_cu);
        (void)hipGetLastError();
        grid = cus;
    }
    if (grid < 0) return;
    (void)hipMemsetAsync((char*)d_ws + WS_CTL, 0, CTL_BYTES, stream);
    Params p{};
    const float** pin = (const float**)&p;
    for (int i = 0; i < 28; ++i) pin[i] = (const float*)d_in[i];
    p.out = (float*)d_out; p.ws = (unsigned char*)d_ws;
#if ONE_LAUNCH
    p.ph_lo = 0; p.ph_hi = NPHASE;
    hipLaunchKernelGGL(fwd, dim3(grid), dim3(NTHR), LDS_BYTES, stream, p);
#else
    for (int k = 0; k < NPHASE; ++k) { p.ph_lo = k; p.ph_hi = k + 1; hipLaunchKernelGGL(fwd, dim3(grid), dim3(NTHR), LDS_BYTES, stream, p); }
#endif
    (void)in_sizes; (void)out_size;
}
```
